# Optimizing an MI355X kernel written in HIP

```python
import jax, jax.numpy as jnp
from jax import lax
import numpy as np

D_MODEL = 1024
BATCH = 32
SEQ = 256
DEPTH = 1
DEC_BATCH = 4
DEC_SEQ = 4096
PAST_LEN = 512

GRID_W = 64
MIX_WIDTH = D_MODEL
POOL_WIDTH = MIX_WIDTH // 2
LRU_WIDTH = MIX_WIDTH - POOL_WIDTH
IN_WIDTH = POOL_WIDTH + 2 * LRU_WIDTH
POOL_WINDOWS = (2, 4, 8, 16)
POOL_GROUPS = len(POOL_WINDOWS)
POOL_GROUP_DIM = POOL_WIDTH // POOL_GROUPS
LRU_HEADS = 8
LRU_HEAD_DIM = LRU_WIDTH // LRU_HEADS
CONV_WIDTH = 4
CONV_LEFT = 2
LRU_C = 8.0
N_DIRS = 2
D_FF = ((8 * D_MODEL + 3 * 256 - 1) // (3 * 256)) * 256
N_MOD = 6
NORM_EPS = 1e-6

kernel_name = 'hymba_pool_rglru_prefix_dit_step'


def rmsnorm(x, g):
    xf = x.astype(jnp.float32)
    y = xf * lax.rsqrt(jnp.mean(xf * xf, axis=-1, keepdims=True) + NORM_EPS) * g.astype(jnp.float32)
    return y.astype(x.dtype)


def modulation(cvec, w_mod, b_mod):
    m = jax.nn.silu(cvec) @ w_mod + b_mod
    return jnp.split(m[..., None, :], N_MOD, axis=-1)


def window_mean_minus_self(x, w):
    n, L, ch = x.shape
    cs = jnp.concatenate([jnp.zeros((n, 1, ch), x.dtype), jnp.cumsum(x, axis=1)], axis=1)
    t = jnp.arange(L)
    left = w // 2
    right = w - 1 - left
    lo = jnp.clip(t - left, 0, L)
    hi = jnp.clip(t + right + 1, 0, L)
    s = cs[:, hi] - cs[:, lo]
    cnt = (hi - lo).astype(x.dtype)[None, :, None]
    return s / cnt - x


def pool_mixer(u, w_pool, pool_scale, grid):
    b, L, _ = u.shape
    uf = u.astype(jnp.float32)
    if grid:
        rows = L // GRID_W
        uf = uf.reshape(b * rows, GRID_W, POOL_WIDTH)
    groups = [window_mean_minus_self(uf[..., g * POOL_GROUP_DIM:(g + 1) * POOL_GROUP_DIM], w)
              for g, w in enumerate(POOL_WINDOWS)]
    m = jnp.stack(groups, axis=-2).reshape(b, L, POOL_GROUPS, POOL_GROUP_DIM)
    y = jnp.einsum('blgc,gcd->blgd', m, w_pool.astype(jnp.float32)).reshape(b, L, POOL_WIDTH)
    return (y * pool_scale.astype(jnp.float32)).astype(u.dtype)


def centred_dwconv(x, w, bias):
    L = x.shape[1]
    xp = jnp.pad(x, ((0, 0), (CONV_LEFT, CONV_WIDTH - 1 - CONV_LEFT), (0, 0)))
    wf = w.astype(jnp.float32)
    out = xp[:, 0:L] * wf[0]
    for k in range(1, CONV_WIDTH):
        out = out + xp[:, k:k + L] * wf[k]
    return out + bias.astype(jnp.float32)


def linear_scan(a, bterm, h0, reverse):
    if reverse:
        bterm = bterm.at[:, -1].add(a[:, -1] * h0)
    else:
        bterm = bterm.at[:, 0].add(a[:, 0] * h0)

    def combine(p, q):
        a1, b1 = p
        a2, b2 = q
        return a1 * a2, a2 * b1 + b2

    _, h = lax.associative_scan(combine, (a, bterm), reverse=reverse, axis=1)
    return h


def rg_lru_bidir(xb, w_a, b_a, w_x, b_x, lam, h0):
    b, L, _ = xb.shape
    xh = xb.reshape(b, L, LRU_HEADS, LRU_HEAD_DIM)
    y = None
    finals = []
    for d in range(N_DIRS):
        r = jax.nn.sigmoid(jnp.einsum('blhi,hij->blhj', xh, w_a[d].astype(jnp.float32)).reshape(b, L, LRU_WIDTH)
                           + b_a[d].astype(jnp.float32))
        i = jax.nn.sigmoid(jnp.einsum('blhi,hij->blhj', xh, w_x[d].astype(jnp.float32)).reshape(b, L, LRU_WIDTH)
                           + b_x[d].astype(jnp.float32))
        log_a = LRU_C * r * jax.nn.log_sigmoid(lam[d].astype(jnp.float32))
        a = jnp.exp(log_a)
        mult = jnp.sqrt(jnp.maximum(-jnp.expm1(2.0 * log_a), 0.0))
        h = linear_scan(a, mult * (i * xb), h0[:, d], reverse=(d == 1))
        finals.append(h[:, -1] if d == 0 else h[:, 0])
        y = h if y is None else y + h
    return y, jnp.stack(finals, axis=1)


def trunk_layer(x, cvec, h0, grid, p):
    shift1, scale1, gate1, shift2, scale2, gate2 = modulation(cvec, p['w_mod'], p['b_mod'])
    h = rmsnorm(x, p['norm_mix_pre']) * (1.0 + scale1) + shift1
    u = h @ p['w_in']
    u_pool = u[..., :POOL_WIDTH]
    u_x = u[..., POOL_WIDTH:POOL_WIDTH + LRU_WIDTH]
    u_gate = u[..., POOL_WIDTH + LRU_WIDTH:]
    y_pool = pool_mixer(u_pool, p['w_pool'], p['pool_scale'], grid)
    xb = centred_dwconv(u_x.astype(jnp.float32), p['conv_w'], p['conv_b'])
    y_lru, h_final = rg_lru_bidir(xb, p['lru_w_a'], p['lru_b_a'], p['lru_w_x'], p['lru_b_x'],
                                  p['lru_lambda'], h0)
    y_lru = (y_lru * jax.nn.gelu(u_gate.astype(jnp.float32))).astype(x.dtype)
    mix = jnp.concatenate([y_pool, y_lru], axis=-1) @ p['w_out']
    x = x + gate1 * rmsnorm(mix, p['norm_mix_post'])
    h2 = rmsnorm(x, p['norm_ffn_pre']) * (1.0 + scale2) + shift2
    gu = h2 @ p['w_ffn_in']
    ff = (jax.nn.silu(gu[..., :D_FF]) * gu[..., D_FF:]) @ p['w_ffn_out']
    x = x + gate2 * rmsnorm(ff, p['norm_ffn_post'])
    return x, h_final


def setup_inputs(seed: int = 0) -> dict:
    key = jax.random.key(seed)
    ks = jax.random.split(key, 24)
    f32 = jnp.float32
    nrm = lambda k, shape, s: jax.random.normal(k, shape, f32) * s
    a0 = jax.random.uniform(ks[20], (DEPTH, N_DIRS, LRU_WIDTH), f32, minval=0.9, maxval=0.999)
    s0 = a0 ** (1.0 / LRU_C)
    lam = jnp.log(s0) - jnp.log1p(-s0)
    return {
        'x_prompt': nrm(ks[0], (BATCH, SEQ, D_MODEL), 1.0),
        'x_sample': nrm(ks[1], (DEC_BATCH, DEC_SEQ, D_MODEL), 1.0),
        'c': nrm(ks[2], (DEC_BATCH, D_MODEL), 1.0),
        'state_lru': nrm(ks[3], (DEC_BATCH, DEPTH, N_DIRS, LRU_WIDTH), 0.5),
        'c_ctx': nrm(ks[4], (D_MODEL,), 1.0),
        'w_mod': nrm(ks[5], (DEPTH, D_MODEL, N_MOD * D_MODEL), D_MODEL ** -0.5),
        'b_mod': nrm(ks[6], (DEPTH, N_MOD * D_MODEL), 0.01),
        'norm_mix_pre': 1.0 + nrm(ks[7], (DEPTH, D_MODEL), 0.05),
        'norm_mix_post': 1.0 + nrm(ks[8], (DEPTH, D_MODEL), 0.05),
        'norm_ffn_pre': 1.0 + nrm(ks[9], (DEPTH, D_MODEL), 0.05),
        'norm_ffn_post': 1.0 + nrm(ks[10], (DEPTH, D_MODEL), 0.05),
        'w_in': nrm(ks[11], (DEPTH, D_MODEL, IN_WIDTH), D_MODEL ** -0.5),
        'w_pool': nrm(ks[12], (DEPTH, POOL_GROUPS, POOL_GROUP_DIM, POOL_GROUP_DIM), POOL_GROUP_DIM ** -0.5),
        'pool_scale': 1.0 + nrm(ks[13], (DEPTH, POOL_WIDTH), 0.1),
        'conv_w': nrm(ks[14], (DEPTH, CONV_WIDTH, LRU_WIDTH), CONV_WIDTH ** -0.5),
        'conv_b': nrm(ks[15], (DEPTH, LRU_WIDTH), 0.01),
        'lru_w_a': nrm(ks[16], (DEPTH, N_DIRS, LRU_HEADS, LRU_HEAD_DIM, LRU_HEAD_DIM), LRU_HEAD_DIM ** -0.5),
        'lru_b_a': nrm(ks[17], (DEPTH, N_DIRS, LRU_WIDTH), 0.01),
        'lru_w_x': nrm(ks[18], (DEPTH, N_DIRS, LRU_HEADS, LRU_HEAD_DIM, LRU_HEAD_DIM), LRU_HEAD_DIM ** -0.5),
        'lru_b_x': nrm(ks[19], (DEPTH, N_DIRS, LRU_WIDTH), 0.01),
        'lru_lambda': lam,
        'w_out': nrm(ks[21], (DEPTH, MIX_WIDTH, D_MODEL), MIX_WIDTH ** -0.5),
        'w_ffn_in': nrm(ks[22], (DEPTH, D_MODEL, 2 * D_FF), D_MODEL ** -0.5),
        'w_ffn_out': nrm(ks[23], (DEPTH, D_FF, D_MODEL), D_FF ** -0.5),
    }


def reference(x_prompt, x_sample, c, state_lru, c_ctx, w_mod, b_mod, norm_mix_pre, norm_mix_post,
              norm_ffn_pre, norm_ffn_post, w_in, w_pool, pool_scale, conv_w, conv_b,
              lru_w_a, lru_b_a, lru_w_x, lru_b_x, lru_lambda, w_out, w_ffn_in, w_ffn_out):
    y_prompt = x_prompt
    y_sample = x_sample
    h0_ctx = jnp.zeros((x_prompt.shape[0], N_DIRS, LRU_WIDTH), jnp.float32)
    ctx_states = []
    for l in range(DEPTH):
        p = {
            'w_mod': w_mod[l], 'b_mod': b_mod[l],
            'norm_mix_pre': norm_mix_pre[l], 'norm_mix_post': norm_mix_post[l],
            'norm_ffn_pre': norm_ffn_pre[l], 'norm_ffn_post': norm_ffn_post[l],
            'w_in': w_in[l], 'w_pool': w_pool[l], 'pool_scale': pool_scale[l],
            'conv_w': conv_w[l], 'conv_b': conv_b[l],
            'lru_w_a': lru_w_a[l], 'lru_b_a': lru_b_a[l],
            'lru_w_x': lru_w_x[l], 'lru_b_x': lru_b_x[l], 'lru_lambda': lru_lambda[l],
            'w_out': w_out[l], 'w_ffn_in': w_ffn_in[l], 'w_ffn_out': w_ffn_out[l],
        }
        y_prompt, h_ctx = trunk_layer(y_prompt, c_ctx, h0_ctx, False, p)
        ctx_states.append(h_ctx)
        y_sample, _ = trunk_layer(y_sample, c, state_lru[:, l].astype(jnp.float32), True, p)
    new_state_lru = jnp.stack(ctx_states, axis=1).astype(x_prompt.dtype)
    return (y_prompt, y_sample, new_state_lru)
```

```cpp
#include <hip/hip_runtime.h>
#include <cstdio>
#include <cstdint>
namespace pg8 {
#define PG8_LAS __attribute__((address_space(3)))
typedef unsigned short bf16_t;
typedef short bf16x8 __attribute__((ext_vector_type(8)));
typedef float f32x4 __attribute__((ext_vector_type(4)));
typedef unsigned u32x4 __attribute__((ext_vector_type(4)));
constexpr int BM = 256, BK = 64, HALF = 128, HTB = HALF * BK * 2  , STAGE_BYTES = 8 * HTB, NXCD = 8, WGM = 8;

__host__ __device__ __forceinline__ int lds_byte(int r, int c) { const int st = (r >> 4) * 2 + (c >> 5), rr = r & 15, cc = c & 31, ob = rr * 64 + cc * 2; return st * 1024 + (ob ^ (((ob >> 9) & 1) << 5)); }
__host__ __device__ __forceinline__ void stage_rc(int b, int& R, int& C) { const int st = b / 1024, sb = b % 1024, swz = sb ^ (((sb >> 9) & 1) << 5); R = (st >> 1) * 16 + swz / 64; C = (st & 1) * 32 + (swz % 64) / 2; }
__host__ __device__ __forceinline__ int perm32(int rho) { const int n = rho >> 4, i = rho & 15; return 8 * (i >> 2) + 4 * n + (i & 3); }

struct Unit { int pm, pn; };
struct Gemm { const bf16_t* A; const bf16_t* Bt; int M, N, K; };

struct StaticOrder {
    int nM, nN, nwg, G, c;
    __host__ __device__ void init(int M, int N, int G_, int c_) { nM = M / BM; nN = N / BM; nwg = nM * nN; G = G_; c = c_; }
    __host__ __device__ bool next(int i, Unit& u) const {
        const long L = (long)i * G + c; if (L >= nwg) return false;
        int wgid = (int)L; { const int q = nwg / NXCD, r = nwg % NXCD, xcd = wgid % NXCD, off = wgid / NXCD; wgid = (xcd < r ? xcd * (q + 1) : r * (q + 1) + (xcd - r) * q) + off; }
        const int nig = WGM * nN, gid = wgid / nig, fm = gid * WGM, gsz = (nM - fm) < WGM ? (nM - fm) : WGM;
        u.pm = fm + ((wgid % nig) % gsz); u.pn = (wgid % nig) / gsz; return true;
    }
    __device__ __forceinline__ void a_ready(const Unit&) const {}
    __device__ __forceinline__ void done(const Unit&) const {}
};

__device__ __forceinline__ unsigned cvt_pk_bf16(float lo, float hi) { unsigned r; asm volatile("v_cvt_pk_bf16_f32 %0, %1, %2" : "=v"(r) : "v"(lo), "v"(hi)); return r; }
typedef float f32x2 __attribute__((ext_vector_type(2)));
__device__ __forceinline__ f32x2 gelu_pk(f32x2 v) {
    const f32x2 av = __builtin_elementwise_abs(v), d = av * 0.2316418882f + 1.0f;
    f32x2 t; t.x = __builtin_amdgcn_rcpf(d.x); t.y = __builtin_amdgcn_rcpf(d.y);
    f32x2 q = t * 0.5307027145f + (-0.7265760135f); q = q * t + 0.7107068705f; q = q * t + (-0.142248368f); q = q * t + 0.127414796f; q = q * t;
    const f32x2 s = (v * v) * (-0.72134752044f);
    f32x2 e; e.x = __builtin_amdgcn_exp2f(s.x); e.y = __builtin_amdgcn_exp2f(s.y);
    const f32x2 m = v * (q * e), r = v - m;
    f32x2 o; o.x = v.x < 0.f ? m.x : r.x; o.y = v.y < 0.f ? m.y : r.y; return o;
}

template <int ACT  > struct EpiBf16 {
    static constexpr bool PERM = true, AFTER_DRAIN = false; static_assert(ACT == 0 || ACT == 1, "EpiBf16: ACT is 0 (none) or 1 (gelu_pk)");
    bf16_t* O; int ldc; const float* bias; int split_cols; size_t split_stride; float scale0;
    __device__ __forceinline__ void operator()(const f32x4 (&acc)[2][2][4][2], const Unit& u, int wr, int wc, int fr, int fq) const {
        const int row0 = u.pm * BM + wr * 64 + fr; int colt = u.pn * BM; bf16_t* base = O;
        float sc = 1.f; if (split_cols) { const int t = colt / split_cols; base += (size_t)t * split_stride; colt -= t * split_cols; if (t == 0) sc = scale0; }
        const int col0 = colt + wc * 32 + 8 * fq, bcol0 = u.pn * BM + wc * 32 + 8 * fq;
        f32x4 bv[2][2];
#pragma unroll
        for (int bj = 0; bj < 2; ++bj)
#pragma unroll
            for (int n = 0; n < 2; ++n) bv[bj][n] = bias ? *(const f32x4*)(bias + bcol0 + bj * HALF + 4 * n) : (f32x4){0.f, 0.f, 0.f, 0.f};
#pragma unroll
        for (int ai = 0; ai < 2; ++ai)
#pragma unroll
            for (int m = 0; m < 4; ++m) { bf16_t* rowp = base + (size_t)(row0 + ai * HALF + m * 16) * ldc + col0;
#pragma unroll
                for (int bj = 0; bj < 2; ++bj) { f32x4 v0 = acc[ai][bj][m][0] + bv[bj][0], v1 = acc[ai][bj][m][1] + bv[bj][1];
                    if (ACT == 1) { f32x2 a = gelu_pk((f32x2){v0[0], v0[1]}), b = gelu_pk((f32x2){v0[2], v0[3]}), c = gelu_pk((f32x2){v1[0], v1[1]}), d = gelu_pk((f32x2){v1[2], v1[3]});
                        v0 = (f32x4){a.x, a.y, b.x, b.y}; v1 = (f32x4){c.x, c.y, d.x, d.y}; }
                    v0 = v0 * sc; v1 = v1 * sc; u32x4 w; w.x = cvt_pk_bf16(v0[0], v0[1]); w.y = cvt_pk_bf16(v0[2], v0[3]); w.z = cvt_pk_bf16(v1[0], v1[1]); w.w = cvt_pk_bf16(v1[2], v1[3]);
                    *(u32x4*)(rowp + bj * HALF) = w; } }
    }
};
struct EpiF32 {
    static constexpr bool PERM = false, AFTER_DRAIN = false;
    float* C; int ldc;
    __device__ __forceinline__ void operator()(const f32x4 (&acc)[2][2][4][2], const Unit& u, int wr, int wc, int fr, int fq) const {
        const int row0 = u.pm * BM + wr * 64 + fr, col0 = u.pn * BM + wc * 32 + 4 * fq;
#pragma unroll
        for (int ai = 0; ai < 2; ++ai)
#pragma unroll
            for (int m = 0; m < 4; ++m) { float* rowp = C + (size_t)(row0 + ai * HALF + m * 16) * ldc + col0;
#pragma unroll
                for (int bj = 0; bj < 2; ++bj)
#pragma unroll
                    for (int n = 0; n < 2; ++n) *(f32x4*)(rowp + bj * HALF + n * 16) = acc[ai][bj][m][n]; }
    }
};
struct EpiSwiglu {
    static constexpr bool PERM = true, AFTER_DRAIN = false;
    bf16_t* O; int ldc;
    __device__ __forceinline__ void operator()(const f32x4 (&acc)[2][2][4][2], const Unit& u, int wr, int wc, int fr, int fq) const {
        const int row0 = u.pm * BM + wr * 64 + fr, col0 = u.pn * HALF + wc * 32 + 8 * fq;
#pragma unroll
        for (int ai = 0; ai < 2; ++ai)
#pragma unroll
            for (int m = 0; m < 4; ++m) { bf16_t* rowp = O + (size_t)(row0 + ai * HALF + m * 16) * ldc + col0;
                float o[8];
#pragma unroll
                for (int n = 0; n < 2; ++n)
#pragma unroll
                    for (int e = 0; e < 4; ++e) { const float g = acc[ai][0][m][n][e], up = acc[ai][1][m][n][e];
                        o[4 * n + e] = g * __builtin_amdgcn_rcpf(1.0f + __builtin_amdgcn_exp2f(-1.4426950408889634f * g)) * up; }
                u32x4 w; w.x = cvt_pk_bf16(o[0], o[1]); w.y = cvt_pk_bf16(o[2], o[3]); w.z = cvt_pk_bf16(o[4], o[5]); w.w = cvt_pk_bf16(o[6], o[7]);
                *(u32x4*)rowp = w; }
    }
};

template <class Epi, class Sched, bool ALIGN_EPI = false, bool SP2 = false>
__device__ __forceinline__ void gemm_phase(PG8_LAS unsigned char* lds, const Gemm g, const Sched& S, const Epi& E) {
    const int tid = threadIdx.x, wid = __builtin_amdgcn_readfirstlane(tid >> 6), lane = tid & 63, wr = wid >> 2, wc = wid & 3, fr = lane & 15, fq = lane >> 4;
    const int K = g.K, nt = K / BK;
    unsigned voffA[2], voffB[2];
#pragma unroll
    for (int i = 0; i < 2; ++i) { int R, C; stage_rc(tid * 16 + i * 8192, R, C); const int Rb = Epi::PERM ? ((R & ~31) + perm32(R & 31)) : R;
        voffA[i] = (unsigned)(R * K + C) * 2u; voffB[i] = (unsigned)(Rb * K + C) * 2u; }
    const size_t kstep = (size_t)(BK * 2);
    const size_t hstep = (size_t)HALF * K * 2;
    const size_t tstep = 2 * hstep;
    const unsigned ldsw = (unsigned)wid * 1024u;
    const int aoff = lds_byte(wr * 64 + fr, fq * 8), boff = lds_byte(wc * 32 + fr, fq * 8);
#define PG8_SA(b, h) (((b) * 2 + (h)) * HTB)
#define PG8_SB(b, h) ((4 + (b) * 2 + (h)) * HTB)
#define PG8_STAGE(bufoff, gbase, voff) do { _Pragma("unroll") for (int _i = 0; _i < 2; ++_i) \
        __builtin_amdgcn_global_load_lds((const unsigned*)((const char*)(gbase) + (voff)[_i]), (PG8_LAS unsigned*)(lds + (bufoff) + ldsw + _i * 8192), 16, 0, 0); } while (0)
#define PG8_LDA(dst, b, h) do { _Pragma("unroll") for (int m = 0; m < 4; ++m) _Pragma("unroll") for (int k = 0; k < 2; ++k) dst[m][k] = *(const PG8_LAS bf16x8*)(lds + PG8_SA(b, h) + aoff + m * 2048 + k * 1024); } while (0)
#define PG8_LDB(dst, b, h) do { _Pragma("unroll") for (int n = 0; n < 2; ++n) _Pragma("unroll") for (int k = 0; k < 2; ++k) dst[n][k] = *(const PG8_LAS bf16x8*)(lds + PG8_SB(b, h) + boff + n * 2048 + k * 1024); } while (0)
#define PG8_MMA(ai, bj, At, Bt) do { __builtin_amdgcn_s_setprio(1); _Pragma("unroll") for (int m = 0; m < 4; ++m) _Pragma("unroll") for (int n = 0; n < 2; ++n) _Pragma("unroll") for (int k = 0; k < 2; ++k) \
        acc[ai][bj][m][n] = __builtin_amdgcn_mfma_f32_16x16x32_bf16(Bt[n][k], At[m][k], acc[ai][bj][m][n], 0, 0, 0); __builtin_amdgcn_s_setprio(0); } while (0)
#define PG8_WAIT_V(n) asm volatile("s_waitcnt vmcnt(" #n ")" ::: "memory")
#define PG8_WAIT_L(n) asm volatile("s_waitcnt lgkmcnt(" #n ")" ::: "memory")
#define PG8_BAR __builtin_amdgcn_s_barrier()
#define PG8_SCHED __builtin_amdgcn_sched_barrier(0)
    Unit cur, nxt; int ui = 0;
    if (!S.next(0, cur)) return;
    f32x4 acc[2][2][4][2];
#pragma unroll
    for (int a = 0; a < 2; ++a)
#pragma unroll
        for (int b = 0; b < 2; ++b)
#pragma unroll
            for (int m = 0; m < 4; ++m)
#pragma unroll
                for (int n = 0; n < 2; ++n) acc[a][b][m][n] = (f32x4){0.f, 0.f, 0.f, 0.f};
    bf16x8 At[4][2], B0[2][2], B1[2][2];
    const char* cA = (const char*)g.A + (size_t)cur.pm * tstep; const char* cB = (const char*)g.Bt + (size_t)cur.pn * tstep;
    S.a_ready(cur);
    if constexpr (SP2) {
        PG8_STAGE(PG8_SB(0, 0), cB, voffB); PG8_STAGE(PG8_SB(0, 1), cB + hstep, voffB); PG8_STAGE(PG8_SA(0, 0), cA, voffA); PG8_STAGE(PG8_SA(0, 1), cA + hstep, voffA);
        if (wr == 1) PG8_BAR;
        PG8_WAIT_V(2); PG8_BAR;
        PG8_STAGE(PG8_SB(1, 0), cB + kstep, voffB); PG8_STAGE(PG8_SA(1, 0), cA + kstep, voffA); PG8_STAGE(PG8_SB(1, 1), cB + hstep + kstep, voffB);
        PG8_WAIT_V(6); PG8_BAR;
    } else {
        PG8_STAGE(PG8_SB(0, 0), cB, voffB); PG8_STAGE(PG8_SA(0, 0), cA, voffA); PG8_STAGE(PG8_SB(0, 1), cB + hstep, voffB); PG8_STAGE(PG8_SA(0, 1), cA + hstep, voffA);
        if (wr == 1) PG8_BAR;
        PG8_WAIT_V(4); PG8_BAR;
        PG8_STAGE(PG8_SB(1, 0), cB + kstep, voffB); PG8_STAGE(PG8_SA(1, 0), cA + kstep, voffA); PG8_STAGE(PG8_SB(1, 1), cB + hstep + kstep, voffB);
        PG8_WAIT_V(6); PG8_BAR;
    }
    for (;;) {
        const bool has_next = S.next(ui + 1, nxt);
        const char* nA = has_next ? (const char*)g.A + (size_t)nxt.pm * tstep : cA; const char* nB = has_next ? (const char*)g.Bt + (size_t)nxt.pn * tstep : cB;
        for (int t = 0; t < nt; t += 2) {
            const bool last = (t == nt - 2);
            const char* a1 = cA + (size_t)(t + 1) * kstep;
            const char* a2 = last ? nA : cA + (size_t)(t + 2) * kstep; const char* b2 = last ? nB : cB + (size_t)(t + 2) * kstep;
            const char* a3 = a2 + kstep; const char* b3 = b2 + kstep;
            if (last && has_next) S.a_ready(nxt);
            if constexpr (SP2) {
            PG8_LDB(B0, 0, 0); PG8_LDB(B1, 0, 1); PG8_SCHED; PG8_LDA(At, 0, 0); PG8_STAGE(PG8_SA(1, 1), a1 + hstep, voffA);
            PG8_WAIT_V(8); PG8_WAIT_L(0); PG8_BAR; PG8_MMA(0, 0, At, B0); PG8_MMA(0, 1, At, B1); PG8_BAR; PG8_SCHED;
            PG8_LDA(At, 0, 1); PG8_STAGE(PG8_SB(0, 0), b2, voffB); PG8_STAGE(PG8_SB(0, 1), b2 + hstep, voffB); PG8_STAGE(PG8_SA(0, 0), a2, voffA);
            PG8_WAIT_V(8); PG8_WAIT_L(0); PG8_BAR; PG8_MMA(1, 0, At, B0); PG8_MMA(1, 1, At, B1); PG8_BAR; PG8_SCHED;
            PG8_LDB(B0, 1, 0); PG8_LDB(B1, 1, 1); PG8_SCHED; PG8_LDA(At, 1, 0); PG8_STAGE(PG8_SA(0, 1), a2 + hstep, voffA);
            PG8_WAIT_V(8); PG8_WAIT_L(0); PG8_BAR; PG8_MMA(0, 0, At, B0); PG8_MMA(0, 1, At, B1); PG8_BAR; PG8_SCHED;
            PG8_LDA(At, 1, 1); PG8_STAGE(PG8_SB(1, 0), b3, voffB); PG8_STAGE(PG8_SB(1, 1), b3 + hstep, voffB); PG8_STAGE(PG8_SA(1, 0), a3, voffA);
            PG8_WAIT_V(8); PG8_WAIT_L(0); PG8_BAR; PG8_MMA(1, 0, At, B0); PG8_MMA(1, 1, At, B1); PG8_BAR; PG8_SCHED;
            } else {
            PG8_LDB(B0, 0, 0); PG8_SCHED; PG8_LDA(At, 0, 0); PG8_STAGE(PG8_SA(1, 1), a1 + hstep, voffA);
            PG8_WAIT_L(8); PG8_BAR; PG8_WAIT_L(0); PG8_MMA(0, 0, At, B0); PG8_BAR; PG8_SCHED;
            PG8_LDB(B1, 0, 1); PG8_STAGE(PG8_SB(0, 0), b2, voffB);
            PG8_BAR; PG8_WAIT_L(0); PG8_MMA(0, 1, At, B1); PG8_BAR;
            PG8_LDA(At, 0, 1); PG8_STAGE(PG8_SA(0, 0), a2, voffA);
            PG8_BAR; PG8_WAIT_L(0); PG8_MMA(1, 0, At, B0); PG8_BAR; PG8_SCHED;
            PG8_STAGE(PG8_SB(0, 1), b2 + hstep, voffB);
            PG8_WAIT_V(6); PG8_BAR; PG8_MMA(1, 1, At, B1); PG8_BAR;
            PG8_LDB(B0, 1, 0); PG8_SCHED; PG8_LDA(At, 1, 0); PG8_STAGE(PG8_SA(0, 1), a2 + hstep, voffA);
            PG8_WAIT_L(8); PG8_BAR; PG8_WAIT_L(0); PG8_MMA(0, 0, At, B0); PG8_BAR; PG8_SCHED;
            PG8_LDB(B1, 1, 1); PG8_STAGE(PG8_SB(1, 0), b3, voffB);
            PG8_BAR; PG8_WAIT_L(0); PG8_MMA(0, 1, At, B1); PG8_BAR;
            PG8_LDA(At, 1, 1); PG8_STAGE(PG8_SA(1, 0), a3, voffA);
            PG8_BAR; PG8_WAIT_L(0); PG8_MMA(1, 0, At, B0); PG8_BAR; PG8_SCHED;
            PG8_STAGE(PG8_SB(1, 1), b3 + hstep, voffB);
            PG8_WAIT_V(6); PG8_BAR; PG8_MMA(1, 1, At, B1); PG8_BAR;
            }
        }
        if constexpr (ALIGN_EPI) { if (wr == 0) PG8_BAR; }
        if constexpr (!Epi::AFTER_DRAIN) { E(acc, cur, wr, wc, fr, fq); S.done(cur); }
        if (!has_next) break;
#pragma unroll
        for (int a = 0; a < 2; ++a)
#pragma unroll
            for (int b = 0; b < 2; ++b)
#pragma unroll
                for (int m = 0; m < 4; ++m)
#pragma unroll
                    for (int n = 0; n < 2; ++n) acc[a][b][m][n] = (f32x4){0.f, 0.f, 0.f, 0.f};
        cur = nxt; cA = nA; cB = nB; ++ui;
        if constexpr (ALIGN_EPI) { if (wr == 1) PG8_BAR; }
    }
    PG8_WAIT_V(0);
    if constexpr (!ALIGN_EPI) { if (wr == 0) PG8_BAR; }
    PG8_BAR;
    if constexpr (Epi::AFTER_DRAIN) { E.fused(acc, cur, wr, wc, fr, fq, lds, wid, lane); S.done(cur); }
#undef PG8_SA
#undef PG8_SB
#undef PG8_STAGE
#undef PG8_LDA
#undef PG8_LDB
#undef PG8_MMA
#undef PG8_WAIT_V
#undef PG8_WAIT_L
#undef PG8_BAR
#undef PG8_SCHED
}
}

constexpr int NWAVES = 8;
#ifndef MK_ONE_LAUNCH
#define MK_ONE_LAUNCH 1
#endif
constexpr int N_PHASES = 10;

constexpr int D = 1024, NB = 32, SEQ = 256, DB = 4, DSEQ = 4096, GRIDW = 64;
constexpr int MP = NB * SEQ, MS = DB * DSEQ, M = MP + MS;
constexpr int NIN = 1536, PW = 512, LW = 512, DFF = 2816, NMOD = 6 * D, NHEAD = 8, HD = 64;
constexpr int NCH = M / 256, NCH_P = MP / 256, NCH_S = MS / 256;
constexpr float EPS = 1e-6f;

constexpr size_t MiB = 1u << 20, KiB = 1u << 10;
constexpr size_t WS_CTL = 0, CTL_ZERO_BYTES = 1 * MiB;
constexpr size_t WS_MOD = 64 * KiB;
constexpr size_t WS_WIN = 1 * MiB, WS_WOUT = 4 * MiB, WS_WFI = 6 * MiB, WS_WFO = 17 * MiB;
constexpr size_t WS_WCAT = 23 * MiB, WS_WPT = WS_WCAT + 256 * KiB, WS_LSC = WS_WPT + 128 * KiB, WS_CAGG = WS_WCAT + 512 * KiB;
constexpr size_t WS_XN = 24 * MiB;
constexpr size_t WS_U = 72 * MiB;
constexpr size_t WS_ACT = 124 * MiB;
constexpr size_t WS_END = 256 * MiB;
static_assert(WS_WFO + (size_t)D * DFF * 2 <= WS_WCAT && WS_CAGG + (size_t)NCH_S * 2 * LW * 8 <= WS_XN && WS_ACT + (size_t)M * DFF * 2 <= WS_END && WS_MOD + 5 * NMOD * 4 <= CTL_ZERO_BYTES, "d_ws map");
constexpr int CW_BAR = 4096;

constexpr int LDS_BYTES = 147456;
constexpr int MISC_OFF = LDS_BYTES - 256;
constexpr int RING_OFF = 0;

#define GAS __attribute__((address_space(1)))
#define LAS __attribute__((address_space(3)))
typedef unsigned short bf16;
typedef unsigned v4u __attribute__((ext_vector_type(4)));
typedef unsigned v2u __attribute__((ext_vector_type(2)));
typedef float f32x4 __attribute__((ext_vector_type(4)));
typedef float f32x2 __attribute__((ext_vector_type(2)));
typedef short bf16x8 __attribute__((ext_vector_type(8)));
typedef GAS unsigned gu32;
typedef GAS unsigned long long gu64;
#define RLX_AGENT __ATOMIC_RELAXED, __HIP_MEMORY_SCOPE_AGENT
#define LDS_WAIT() asm volatile("s_waitcnt lgkmcnt(0)" ::: "memory")
#define VM_WAIT() asm volatile("s_waitcnt vmcnt(0)" ::: "memory")
__device__ __forceinline__ unsigned f2bf(float f) { unsigned u = __builtin_bit_cast(unsigned, f); return (u + 0x7fffu + ((u >> 16) & 1u)) >> 16; }
__device__ __forceinline__ unsigned pk2(float lo, float hi) { return f2bf(lo) | (f2bf(hi) << 16); }
__device__ __forceinline__ float bflo(unsigned w) { return __builtin_bit_cast(float, w << 16); }
__device__ __forceinline__ float bfhi(unsigned w) { return __builtin_bit_cast(float, w & 0xffff0000u); }
__device__ __forceinline__ float fsigmoid(float z) { return __builtin_amdgcn_rcpf(1.0f + __builtin_amdgcn_exp2f(-1.4426950408889634f * z)); }

#define XB_TMO      128
#define XB_XCNT(j)  (256  + 64 * (j))
#define XB_XSUB(j)  (1280 + 64 * (j))
#define XB_XGEN(j)  (2304 + 64 * (j))
#define XB_TOP      3328
#define XB_TOPGEN   3392
#define XCD_BAR_WORDS 3456
#define XB_SPIN_CAP (1u << 18)

__device__ __forceinline__ unsigned xb_ld(unsigned* p)              { return __hip_atomic_load(p, __ATOMIC_RELAXED, __HIP_MEMORY_SCOPE_AGENT); }
__device__ __forceinline__ unsigned xb_add(unsigned* p, unsigned v) { return __hip_atomic_fetch_add(p, v, __ATOMIC_RELAXED, __HIP_MEMORY_SCOPE_AGENT); }
__device__ __forceinline__ unsigned xb_xcc_id() { return (unsigned)__builtin_amdgcn_s_getreg((3 << 11) | 20) & 0xFu; }
#define XB_SPIN(cond, bar) do { unsigned _sp = 0; while (cond) { __builtin_amdgcn_s_sleep(1); \
    if ((++_sp & 255u) == 0u) { if (xb_ld(&(bar)[XB_TMO])) break; if (_sp > XB_SPIN_CAP) { atomicAdd(&(bar)[XB_TMO], 1u); break; } } } } while (0)

struct XcdBarrier {
    unsigned* bar; unsigned x;
    volatile LAS unsigned* st;
};

__device__ __forceinline__ XcdBarrier xcd_barrier_post(unsigned* bar, volatile LAS unsigned* st) {
    XcdBarrier b; b.bar = bar; b.x = xb_xcc_id(); b.st = st;
    if (threadIdx.x == 0) (void)xb_add(&bar[XB_XCNT(b.x)], 1u);
    return b;
}
__device__ __forceinline__ void xcd_barrier_complete(unsigned* bar, unsigned x, unsigned& nloc, unsigned& nx) {
    const unsigned G = gridDim.x * gridDim.y * gridDim.z;
    unsigned sum, cnt, mine, sp = 0u;
    for (;;) {
        sum = 0u; cnt = 0u; mine = 0u;
#pragma unroll
        for (unsigned j = 0; j < 16; ++j) { const unsigned c = xb_ld(&bar[XB_XCNT(j)]); sum += c; cnt += (c > 0u) ? 1u : 0u; mine = (j == x) ? c : mine; }
        if (sum == G) break;
        __builtin_amdgcn_s_sleep(1);
        if ((++sp & 255u) == 0u) { if (xb_ld(&bar[XB_TMO])) break; if (sp > XB_SPIN_CAP) { atomicAdd(&bar[XB_TMO], 1u); break; } }
    }
    nloc = mine > 0u ? mine : 1u; nx = cnt > 0u ? cnt : 1u;
}

__device__ __forceinline__ void xcd_barrier(const XcdBarrier& b) {
    asm volatile("s_waitcnt vmcnt(0)" ::: "memory");
    __syncthreads();
    if (threadIdx.x == 0) {
        unsigned* bar = b.bar;
        __builtin_amdgcn_s_waitcnt(0);
        unsigned nloc = b.st[0], nx = b.st[1];
        if (nloc == 0u) { xcd_barrier_complete(bar, b.x, nloc, nx); b.st[0] = nloc; b.st[1] = nx; }
        const unsigned old = xb_add(&bar[XB_XSUB(b.x)], 1u);
        const unsigned gen = old / nloc;
        if (old + 1u == (gen + 1u) * nloc) {
            __builtin_amdgcn_fence(__ATOMIC_RELEASE, "agent");
            asm volatile("s_waitcnt vmcnt(0)" ::: "memory");
            const unsigned og = xb_add(&bar[XB_TOP], 1u);
            const unsigned tg = og / nx;
            if (og + 1u == (tg + 1u) * nx) xb_add(&bar[XB_TOPGEN], 1u);
            else XB_SPIN(xb_ld(&bar[XB_TOPGEN]) == tg, bar);
            __builtin_amdgcn_fence(__ATOMIC_ACQUIRE, "agent");
            xb_add(&bar[XB_XGEN(b.x)], 1u);
            asm volatile("s_waitcnt vmcnt(0)" ::: "memory");
        } else {
            XB_SPIN(xb_ld(&bar[XB_XGEN(b.x)]) == gen, bar);
            __builtin_amdgcn_fence(__ATOMIC_ACQUIRE, "agent");
            asm volatile("s_waitcnt vmcnt(0)" ::: "memory");
        }
    }
    __syncthreads();
}

struct Frame {
    LAS unsigned char* lds;
    volatile LAS unsigned* MISC;
    gu32* ctl;
    int tid, lane, wave;
    int vcu, G;
    const float *xp, *xs, *c, *state, *cctx, *wmod, *bmod, *g_mix_pre, *g_mix_post, *g_ffn_pre, *g_ffn_post, *w_in, *w_pool, *pscale, *convw, *convb, *wa, *ba, *wx, *bx, *lam, *w_out, *w_fi, *w_fo;
    float* out; float* newstate;
    float* MOD;
    bf16 *Win_t, *Wout_t, *Wfi_t, *Wfo_t, *Wcat, *Wpt;
    float* LSC;
    f32x2* CAGG;
    bf16 *XN, *U, *MIX, *H2, *ACT;
    float *MIXO, *FF;
};
__device__ __forceinline__ const float* xrow(const Frame& F, int row) { return row < MP ? F.xp + (size_t)row * D : F.xs + (size_t)(row - MP) * D; }
__device__ __forceinline__ int mod_idx(int row) { return row < MP ? 0 : 1 + (row - MP) / DSEQ; }
__device__ __forceinline__ float wave_sum(float v) {
#pragma unroll
    for (int o = 1; o < 64; o <<= 1) v += __shfl_xor(v, o);
    return v;
}

__device__ __forceinline__ void p0_transpose_item(const float* W, int K, int N, bf16* WT, int k0, int n0, int drow0, LAS float* scr, int lane) {
#pragma unroll 8
    for (int i = 0; i < 32; ++i) { const int kk = 2 * i + (lane >> 5); scr[kk * 33 + (lane & 31)] = W[(size_t)(k0 + kk) * N + n0 + (lane & 31)]; }
    LDS_WAIT(); asm volatile("" ::: "memory");
    const int c = lane & 7;
#pragma unroll
    for (int j = 0; j < 4; ++j) { const int n = (lane >> 3) + 8 * j; const LAS float* s = scr + (8 * c) * 33 + n;
        v4u o; o.x = pk2(s[0 * 33], s[1 * 33]); o.y = pk2(s[2 * 33], s[3 * 33]); o.z = pk2(s[4 * 33], s[5 * 33]); o.w = pk2(s[6 * 33], s[7 * 33]);
        *(GAS v4u*)(WT + (size_t)(drow0 + n) * K + k0 + 8 * c) = o; }
    LDS_WAIT(); asm volatile("" ::: "memory");
}
__device__ __forceinline__ void p0_prologue(Frame& F) {
    LAS float* scr = (LAS float*)(F.lds + RING_OFF + F.wave * 16384);
    const int gw = F.vcu * NWAVES + F.wave, NGW = F.G * NWAVES, lane = F.lane;
    constexpr int MOD_UNITS = (NMOD / 64) * (D / 64);
    for (int it = gw; it < MOD_UNITS; it += NGW) {
        const int cg = it % (NMOD / 64), ks = it / (NMOD / 64), col = cg * 64 + lane, k0 = ks * 64;
        float sv[5];
#pragma unroll
        for (int v = 0; v < 5; ++v) { const float x = v == 0 ? F.cctx[k0 + lane] : F.c[(v - 1) * D + k0 + lane]; sv[v] = x * fsigmoid(x); }
        float acc[5] = {0.f, 0.f, 0.f, 0.f, 0.f};
#pragma unroll 16
        for (int kk = 0; kk < 64; ++kk) { const float w = F.wmod[(size_t)(k0 + kk) * NMOD + col];
#pragma unroll
            for (int v = 0; v < 5; ++v) acc[v] += __shfl(sv[v], kk) * w; }
        const float bm = ks == 0 ? F.bmod[col] : 0.f;
#pragma unroll
        for (int v = 0; v < 5; ++v) atomicAdd(F.MOD + v * NMOD + col, acc[v] + bm);
    }
    constexpr int I_IN = (D / 64) * (NIN / 32), I_OUT = (D / 64) * (D / 32), I_FI = (D / 64) * (2 * DFF / 32), I_FO = (DFF / 64) * (D / 32);
    constexpr int NITEMS = I_IN + I_OUT + I_FI + I_FO;
    for (int it = gw; it < NITEMS; it += NGW) {
        int r = it;
        if (r < I_IN) { const int nblk = NIN / 32, kb = r / nblk, nb = r % nblk; p0_transpose_item(F.w_in, D, NIN, F.Win_t, 64 * kb, 32 * nb, 32 * nb, scr, lane); continue; } r -= I_IN;
        if (r < I_OUT) { const int nblk = D / 32, kb = r / nblk, nb = r % nblk; p0_transpose_item(F.w_out, D, D, F.Wout_t, 64 * kb, 32 * nb, 32 * nb, scr, lane); continue; } r -= I_OUT;
        if (r < I_FI) { const int nblk = 2 * DFF / 32, kb = r / nblk, nb = r % nblk, n0 = 32 * nb;
            const int up = n0 >= DFF ? 1 : 0, j0 = n0 - up * DFF, drow0 = 256 * (j0 / 128) + 128 * up + (j0 % 128);
            p0_transpose_item(F.w_fi, D, 2 * DFF, F.Wfi_t, 64 * kb, n0, drow0, scr, lane); continue; } r -= I_FI;
        { const int nblk = D / 32, kb = r / nblk, nb = r % nblk; p0_transpose_item(F.w_fo, DFF, D, F.Wfo_t, 64 * kb, 32 * nb, 32 * nb, scr, lane); }
    }
    const int gt = F.vcu * NWAVES * 64 + F.tid, NGT = F.G * NWAVES * 64;
    for (int e = gt; e < NHEAD * 256 * 64; e += NGT) { const int i = e & 63, col = (e >> 6) & 255, h = e >> 14, type = col >> 6, j = col & 63, d = type >> 1;
        const float* src = (type & 1) ? F.wx : F.wa; F.Wcat[e] = (bf16)f2bf(src[((size_t)(d * NHEAD + h) * 64 + i) * 64 + j]); }
    for (int e = gt; e < 4 * 128 * 128; e += NGT) { const int c = e & 127, dd = (e >> 7) & 127, g = e >> 14; F.Wpt[e] = (bf16)f2bf(F.w_pool[(size_t)(g * 128 + c) * 128 + dd]); }
    for (int e = gt; e < 2 * LW; e += NGT) F.LSC[e] = -8.0f * 1.4426950408889634f * log1pf(expf(-F.lam[e]));
}

__device__ __forceinline__ void p1_xn(Frame& F) {
    const int gw = F.vcu * NWAVES + F.wave, NGW = F.G * NWAVES, lane = F.lane;
    for (int row = gw; row < M; row += NGW) {
        const GAS f32x4* xr = (const GAS f32x4*)xrow(F, row) + lane; const float* mod = F.MOD + mod_idx(row) * NMOD;
        f32x4 v[4]; float s = 0.f;
#pragma unroll
        for (int j = 0; j < 4; ++j) { v[j] = xr[64 * j]; s += (v[j].x * v[j].x + v[j].y * v[j].y) + (v[j].z * v[j].z + v[j].w * v[j].w); }
        const float r = rsqrtf(wave_sum(s) * (1.f / D) + EPS);
        GAS v2u* o8 = (GAS v2u*)(F.XN + (size_t)row * D) + lane;
#pragma unroll
        for (int j = 0; j < 4; ++j) { const int col = 256 * j + 4 * lane;
            const f32x4 g = *(const GAS f32x4*)(F.g_mix_pre + col), sc = *(const GAS f32x4*)(mod + D + col), sh = *(const GAS f32x4*)(mod + col);
            const f32x4 y = v[j] * r * g * (1.0f + sc) + sh; v2u w; w.x = pk2(y.x, y.y); w.y = pk2(y.z, y.w); o8[64 * j] = w; }
    }
}

constexpr int LSTR = 144, UX_OFF = 0, XB_OFF = 37376, AGG_OFF = 74240, CST_OFF = 107008;
static_assert(XB_OFF >= 259 * LSTR && AGG_OFF >= XB_OFF + 256 * LSTR && CST_OFF >= AGG_OFF + 64 * 2 * 32 * 8 && CST_OFF + 64 * 12 * 4 <= MISC_OFF && 128 * LSTR <= 64 * 2 * 32 * 8, "LRU LDS map");
template <bool FULL>
__device__ __forceinline__ void lru_unit(Frame& F, const int ci, const int hh) {
    int tid = F.tid, w = F.wave; asm volatile("" : "+v"(tid)); asm volatile("" : "+s"(w));
    const int lane = tid & 63, fr = lane & 15, fq = lane >> 4, h = hh >> 1, c32 = (hh & 1) * 32;
    LAS unsigned char* lds = F.lds;
    const int row0 = ci * 256; const bool samp = ci >= NCH_P; const int q = samp ? ((ci - NCH_P) & 15) : 0; const bool has_prev = samp && q > 0, has_next = samp && q < 15;
    for (int idx = tid; idx < 259 * 8; idx += NWAVES * 64) { const int rr = idx >> 3, cg = idx & 7, grow = row0 - 2 + rr;
        const bool valid = (rr >= 2 || has_prev) && (rr < 258 || has_next);
        v4u v = {0u, 0u, 0u, 0u}; if (valid) v = *(const GAS v4u*)(F.U + (size_t)grow * NIN + PW + h * HD + cg * 8);
        *(LAS v4u*)(lds + UX_OFF + rr * LSTR + cg * 16) = v; }
#pragma unroll
    for (int it = 0; it < 2; ++it) { const int idx = tid + it * NWAVES * 64, col = idx >> 3, kc = idx & 7, srow = (col >> 5) * 64 + c32 + (col & 31);
        *(LAS v4u*)(lds + AGG_OFF + col * LSTR + kc * 16) = *(const GAS v4u*)(F.Wcat + ((size_t)(h * 256 + srow) * 64 + kc * 8)); }
    if (tid < 64) { const int chh = h * HD + tid; LAS float* c = (LAS float*)(lds + CST_OFF) + tid * 12;
        c[0] = F.convw[chh]; c[1] = F.convw[LW + chh]; c[2] = F.convw[2 * LW + chh]; c[3] = F.convw[3 * LW + chh]; c[4] = F.convb[chh];
        c[5] = F.ba[chh]; c[6] = F.ba[LW + chh]; c[7] = F.bx[chh]; c[8] = F.bx[LW + chh]; c[9] = F.LSC[chh]; c[10] = F.LSC[LW + chh]; c[11] = 0.f; }
    __syncthreads();
    { const int cg = tid & 7; float cw[4][8], cb[8];
#pragma unroll
      for (int e = 0; e < 8; ++e) { const LAS float* c = (const LAS float*)(lds + CST_OFF) + (cg * 8 + e) * 12; cb[e] = c[4];
#pragma unroll
          for (int k = 0; k < 4; ++k) cw[k][e] = c[k]; }
#pragma unroll
      for (int it = 0; it < 4; ++it) { const int t = (tid >> 3) + 64 * it; float xb[8];
#pragma unroll
          for (int e = 0; e < 8; ++e) xb[e] = cb[e];
#pragma unroll
          for (int k = 0; k < 4; ++k) { const v4u v = *(const LAS v4u*)(lds + UX_OFF + (t + k) * LSTR + cg * 16);
              xb[0] += cw[k][0] * bflo(v.x); xb[1] += cw[k][1] * bfhi(v.x); xb[2] += cw[k][2] * bflo(v.y); xb[3] += cw[k][3] * bfhi(v.y);
              xb[4] += cw[k][4] * bflo(v.z); xb[5] += cw[k][5] * bfhi(v.z); xb[6] += cw[k][6] * bflo(v.w); xb[7] += cw[k][7] * bfhi(v.w); }
          v4u o; o.x = pk2(xb[0], xb[1]); o.y = pk2(xb[2], xb[3]); o.z = pk2(xb[4], xb[5]); o.w = pk2(xb[6], xb[7]);
          *(LAS v4u*)(lds + XB_OFF + t * LSTR + cg * 16) = o; } }
    __syncthreads();
    f32x4 acc[2][8];
#pragma unroll
    for (int mt = 0; mt < 2; ++mt)
#pragma unroll
        for (int nt = 0; nt < 8; ++nt) acc[mt][nt] = (f32x4){0.f, 0.f, 0.f, 0.f};
    { bf16x8 a[2][2];
#pragma unroll
      for (int mt = 0; mt < 2; ++mt)
#pragma unroll
          for (int ks = 0; ks < 2; ++ks) a[mt][ks] = *(const LAS bf16x8*)(lds + XB_OFF + (32 * w + 16 * mt + fr) * LSTR + (32 * ks + 8 * fq) * 2);
#pragma unroll
      for (int nt = 0; nt < 8; ++nt)
#pragma unroll
          for (int ks = 0; ks < 2; ++ks) { const bf16x8 b = *(const LAS bf16x8*)(lds + AGG_OFF + (16 * nt + fr) * LSTR + (32 * ks + 8 * fq) * 2);
#pragma unroll
              for (int mt = 0; mt < 2; ++mt) acc[mt][nt] = __builtin_amdgcn_mfma_f32_16x16x32_bf16(a[mt][ks], b, acc[mt][nt], 0, 0, 0); } }
    __syncthreads();
    if constexpr (FULL) {
        const __amdgpu_buffer_rsrc_t ursrc = __builtin_amdgcn_make_buffer_rsrc((void*)F.U, 0, M * NIN * 2, 0x00020000);
        const int voff = ((lane >> 2) * NIN + (lane & 3) * 8) * 2;
#pragma unroll
        for (int it = 0; it < 2; ++it) { const int r16 = (w * 2 + it) * 16;
            __builtin_amdgcn_raw_ptr_buffer_load_lds(ursrc, (LAS unsigned*)(lds + XB_OFF + r16 * 64), 16, voff, ((row0 + r16) * NIN + PW + LW + h * HD + c32) * 2, 0, 0); }
    }
#pragma unroll
    for (int cq = 0; cq < 2; ++cq) { const int ch = c32 + 16 * cq + fr; const LAS float* c = (const LAS float*)(lds + CST_OFF) + ch * 12;
#pragma unroll
        for (int mt = 0; mt < 2; ++mt) { float ux[7], xbf[4];
#pragma unroll
            for (int r = 0; r < 7; ++r) ux[r] = __builtin_bit_cast(float, (unsigned)(*(const LAS unsigned short*)(lds + UX_OFF + (32 * w + 16 * mt + 4 * fq + r) * LSTR + ch * 2)) << 16);
            { const float cw0 = c[0], cw1 = c[1], cw2 = c[2], cw3 = c[3], cbv = c[4];
#pragma unroll
              for (int i = 0; i < 4; ++i) xbf[i] = cbv + cw0 * ux[i] + cw1 * ux[i + 1] + cw2 * ux[i + 2] + cw3 * ux[i + 3]; }
#pragma unroll
            for (int d = 0; d < 2; ++d) { const float bA = c[5 + d], bX = c[7 + d], c8 = c[9 + d];
#pragma unroll
                for (int i = 0; i < 4; ++i) { const float r = fsigmoid(acc[mt][4 * d + cq][i] + bA), ig = fsigmoid(acc[mt][4 * d + 2 + cq][i] + bX);
                    const float a = __builtin_amdgcn_exp2f(r * c8), mult = __builtin_amdgcn_sqrtf(fmaxf(1.0f - a * a, 0.f));
                    acc[mt][4 * d + cq][i] = a; acc[mt][4 * d + 2 + cq][i] = mult * (ig * xbf[i]); } } } }
#pragma unroll
    for (int d = 0; d < 2; ++d)
#pragma unroll
        for (int cq = 0; cq < 2; ++cq)
#pragma unroll
            for (int mt = 0; mt < 2; ++mt) { const f32x4 a = acc[mt][4 * d + cq], b = acc[mt][4 * d + 2 + cq];
                const float A = (a[0] * a[1]) * (a[2] * a[3]);
                const float B = d == 0 ? ((b[0] * a[1] + b[1]) * a[2] + b[2]) * a[3] + b[3] : ((b[3] * a[2] + b[2]) * a[1] + b[1]) * a[0] + b[0];
                *(LAS f32x2*)(lds + AGG_OFF + (((8 * w + 4 * mt + fq) * 2 + d) * 32 + 16 * cq + fr) * 8) = (f32x2){A, B}; }
    if constexpr (FULL) asm volatile("s_waitcnt vmcnt(0)" ::: "memory");
    __syncthreads();
    if (tid < 64) { const int d = tid >> 5, cl = tid & 31, chh = h * HD + c32 + cl;
        if constexpr (FULL) {
            float hc = 0.f;
            if (samp) { const int b = (ci - NCH_P) >> 4; hc = F.state[(b * 2 + d) * LW + chh]; const f32x2* cg = F.CAGG + ((size_t)(b * 16) * 2 + d) * LW + chh;
                if (d == 0) { for (int qq = 0; qq < q; ++qq) { const f32x2 t = cg[(size_t)qq * 2 * LW]; hc = t.x * hc + t.y; } }
                else { for (int qq = 15; qq > q; --qq) { const f32x2 t = cg[(size_t)qq * 2 * LW]; hc = t.x * hc + t.y; } } }
#pragma unroll 8
            for (int s = 0; s < 64; ++s) { const int g = d == 0 ? s : 63 - s; LAS f32x2* p = (LAS f32x2*)(lds + AGG_OFF + ((g * 2 + d) * 32 + cl) * 8);
                const f32x2 t = *p; *(LAS float*)p = hc; hc = t.x * hc + t.y; }
            if (!samp) F.newstate[(ci * 2 + d) * LW + chh] = hc;
        } else {
            float P = 1.f, Bc = 0.f;
#pragma unroll 8
            for (int s = 0; s < 64; ++s) { const int g = d == 0 ? s : 63 - s; const f32x2 t = *(const LAS f32x2*)(lds + AGG_OFF + ((g * 2 + d) * 32 + cl) * 8);
                Bc = t.x * Bc + t.y; P *= t.x; }
            F.CAGG[((size_t)(ci - NCH_P) * 2 + d) * LW + chh] = (f32x2){P, Bc};
        } }
    if constexpr (FULL) {
        __syncthreads();
#pragma unroll
        for (int cq = 0; cq < 2; ++cq) { const int cl = 16 * cq + fr, chh = h * HD + c32 + cl;
#pragma unroll
            for (int mt = 0; mt < 2; ++mt) { const int g = 8 * w + 4 * mt + fq;
                const f32x4 a0 = acc[mt][cq], b0 = acc[mt][2 + cq], a1 = acc[mt][4 + cq], b1 = acc[mt][6 + cq];
                float hf = *(const LAS float*)(lds + AGG_OFF + ((g * 2 + 0) * 32 + cl) * 8), hb = *(const LAS float*)(lds + AGG_OFF + ((g * 2 + 1) * 32 + cl) * 8);
                float y[4];
#pragma unroll
                for (int i = 0; i < 4; ++i) { hf = a0[i] * hf + b0[i]; y[i] = hf; }
#pragma unroll
                for (int i = 3; i >= 0; --i) { hb = a1[i] * hb + b1[i]; y[i] += hb; }
#pragma unroll
                for (int i = 0; i < 4; ++i) { const int t = 32 * w + 16 * mt + 4 * fq + i;
                    const float x = __builtin_bit_cast(float, (unsigned)(*(const LAS unsigned short*)(lds + XB_OFF + t * 64 + cl * 2)) << 16);
                    const float ge = x * fsigmoid(1.5957691216057308f * (x + 0.044715f * x * x * x));
                    F.MIX[(size_t)(row0 + t) * D + PW + chh] = (bf16)f2bf(y[i] * ge); } } }
    }
    __syncthreads();
}

constexpr int UP_OFF = 0, UP_STRIDE = 256, PM_OFF = 36864, PM_STRIDE = 272;
static_assert(PM_OFF >= 144 * UP_STRIDE && PM_OFF + 128 * PM_STRIDE <= MISC_OFF, "pool LDS map");
__device__ __forceinline__ void pool_unit(Frame& F, const int blk, const int g) {
    int tid = F.tid, w = F.wave; asm volatile("" : "+v"(tid)); asm volatile("" : "+s"(w));
    const int lane = tid & 63, fr = lane & 15, fq = lane >> 4;
    LAS unsigned char* lds = F.lds;
    const int row0 = blk * 128, win = 2 << g, left = win / 2, right = win - 1 - left, segl = row0 < MP ? SEQ : GRIDW;
    for (int idx = tid; idx < 144 * 16; idx += NWAVES * 64) { const int rr = idx >> 4, cg = idx & 15, grow = row0 - 8 + rr;
        if (grow >= 0 && grow < M) *(LAS v4u*)(lds + UP_OFF + rr * UP_STRIDE + cg * 16) = *(const GAS v4u*)(F.U + (size_t)grow * NIN + g * 128 + cg * 8); }
    __syncthreads();
#pragma unroll
    for (int it = 0; it < 4; ++it) { const int idx = tid + it * NWAVES * 64, t = idx >> 4, cg = idx & 15, row = row0 + t;
        const int tl = row < MP ? (row & (SEQ - 1)) : ((row - MP) & (GRIDW - 1)), lo = max(tl - left, 0), hi = min(tl + right + 1, segl);
        const int rbase = t + 8 - tl;
        float s[8] = {0.f, 0.f, 0.f, 0.f, 0.f, 0.f, 0.f, 0.f};
        for (int p = lo; p < hi; ++p) { const v4u v = *(const LAS v4u*)(lds + UP_OFF + (rbase + p) * UP_STRIDE + cg * 16);
            s[0] += bflo(v.x); s[1] += bfhi(v.x); s[2] += bflo(v.y); s[3] += bfhi(v.y); s[4] += bflo(v.z); s[5] += bfhi(v.z); s[6] += bflo(v.w); s[7] += bfhi(v.w); }
        const float inv = 1.0f / (float)(hi - lo);
        const v4u sv = *(const LAS v4u*)(lds + UP_OFF + (t + 8) * UP_STRIDE + cg * 16);
        v4u o; o.x = pk2(s[0] * inv - bflo(sv.x), s[1] * inv - bfhi(sv.x)); o.y = pk2(s[2] * inv - bflo(sv.y), s[3] * inv - bfhi(sv.y));
        o.z = pk2(s[4] * inv - bflo(sv.z), s[5] * inv - bfhi(sv.z)); o.w = pk2(s[6] * inv - bflo(sv.w), s[7] * inv - bfhi(sv.w));
        *(LAS v4u*)(lds + PM_OFF + t * PM_STRIDE + cg * 16) = o; }
    __syncthreads();
    f32x4 acc[8];
#pragma unroll
    for (int nt = 0; nt < 8; ++nt) acc[nt] = (f32x4){0.f, 0.f, 0.f, 0.f};
    { bf16x8 a[4];
#pragma unroll
      for (int ks = 0; ks < 4; ++ks) a[ks] = *(const LAS bf16x8*)(lds + PM_OFF + (16 * w + fr) * PM_STRIDE + (32 * ks + 8 * fq) * 2);
      const GAS bf16x8* wb = (const GAS bf16x8*)(F.Wpt + ((size_t)(g * 128 + fr) * 128 + 8 * fq));
#pragma unroll
      for (int nt = 0; nt < 8; ++nt)
#pragma unroll
          for (int ks = 0; ks < 4; ++ks) acc[nt] = __builtin_amdgcn_mfma_f32_16x16x32_bf16(a[ks], wb[nt * 256 + ks * 4], acc[nt], 0, 0, 0); }
#pragma unroll
    for (int nt = 0; nt < 8; ++nt) { const int dcol = g * 128 + 16 * nt + fr; const float ps = F.pscale[dcol];
#pragma unroll
        for (int i = 0; i < 4; ++i) F.MIX[(size_t)(row0 + 16 * w + 4 * fq + i) * D + dcol] = (bf16)f2bf(acc[nt][i] * ps); }
    __syncthreads();
}

__device__ __forceinline__ void p6_rows(Frame& F) {
    const int gw = F.vcu * NWAVES + F.wave, NGW = F.G * NWAVES, lane = F.lane;
    for (int row = gw; row < M; row += NGW) {
        const GAS f32x4* xr = (const GAS f32x4*)xrow(F, row) + lane; const GAS f32x4* mr = (const GAS f32x4*)(F.MIXO + (size_t)row * D) + lane; const float* mod = F.MOD + mod_idx(row) * NMOD;
        f32x4 v[4], x[4]; float s = 0.f;
#pragma unroll
        for (int j = 0; j < 4; ++j) { v[j] = mr[64 * j]; x[j] = xr[64 * j]; s += (v[j].x * v[j].x + v[j].y * v[j].y) + (v[j].z * v[j].z + v[j].w * v[j].w); }
        const float r = rsqrtf(wave_sum(s) * (1.f / D) + EPS); float s2 = 0.f;
#pragma unroll
        for (int j = 0; j < 4; ++j) { const int col = 256 * j + 4 * lane;
            const f32x4 gp = *(const GAS f32x4*)(F.g_mix_post + col), g1 = *(const GAS f32x4*)(mod + 2 * D + col);
            x[j] = x[j] + g1 * (v[j] * r * gp); s2 += (x[j].x * x[j].x + x[j].y * x[j].y) + (x[j].z * x[j].z + x[j].w * x[j].w); }
        const float r2 = rsqrtf(wave_sum(s2) * (1.f / D) + EPS);
        GAS f32x4* o = (GAS f32x4*)(F.out + (size_t)row * D) + lane; GAS v2u* o8 = (GAS v2u*)(F.H2 + (size_t)row * D) + lane;
#pragma unroll
        for (int j = 0; j < 4; ++j) { const int col = 256 * j + 4 * lane; o[64 * j] = x[j];
            const f32x4 g = *(const GAS f32x4*)(F.g_ffn_pre + col), sc = *(const GAS f32x4*)(mod + 4 * D + col), sh = *(const GAS f32x4*)(mod + 3 * D + col);
            const f32x4 y = x[j] * r2 * g * (1.0f + sc) + sh; v2u wv; wv.x = pk2(y.x, y.y); wv.y = pk2(y.z, y.w); o8[64 * j] = wv; }
    }
}
__device__ __forceinline__ void p9_rows(Frame& F) {
    const int gw = F.vcu * NWAVES + F.wave, NGW = F.G * NWAVES, lane = F.lane;
    for (int row = gw; row < M; row += NGW) {
        GAS f32x4* o = (GAS f32x4*)(F.out + (size_t)row * D) + lane; const GAS f32x4* fr_ = (const GAS f32x4*)(F.FF + (size_t)row * D) + lane; const float* mod = F.MOD + mod_idx(row) * NMOD;
        f32x4 v[4], x[4]; float s = 0.f;
#pragma unroll
        for (int j = 0; j < 4; ++j) { v[j] = fr_[64 * j]; x[j] = o[64 * j]; s += (v[j].x * v[j].x + v[j].y * v[j].y) + (v[j].z * v[j].z + v[j].w * v[j].w); }
        const float r = rsqrtf(wave_sum(s) * (1.f / D) + EPS);
#pragma unroll
        for (int j = 0; j < 4; ++j) { const int col = 256 * j + 4 * lane;
            const f32x4 gp = *(const GAS f32x4*)(F.g_ffn_post + col), g2 = *(const GAS f32x4*)(mod + 5 * D + col);
            o[64 * j] = x[j] + g2 * (v[j] * r * gp); }
    }
}

struct Args { const float* in[24]; float* out; unsigned char* ws; int ph_lo, ph_hi; };
static_assert(sizeof(Args) == 26 * 8 + 8, "Args has no padding");
__global__ void __launch_bounds__(NWAVES * 64, 2) mega_fwd(Args args) {
    extern __shared__ __attribute__((aligned(16))) unsigned char lds[];
    Frame F;
    F.lds = (LAS unsigned char*)lds;
    F.MISC = (volatile LAS unsigned*)(F.lds + MISC_OFF);
    F.tid = threadIdx.x; F.lane = F.tid & 63; F.wave = __builtin_amdgcn_readfirstlane(F.tid >> 6);
    F.G = gridDim.x; { const int bx = blockIdx.x; F.vcu = (F.G % 8 == 0) ? (bx % 8) * (F.G / 8) + bx / 8 : bx; }
    unsigned char* ws = args.ws;
    F.ctl = (gu32*)(ws + WS_CTL);
    F.xp = args.in[0]; F.xs = args.in[1]; F.c = args.in[2]; F.state = args.in[3]; F.cctx = args.in[4]; F.wmod = args.in[5]; F.bmod = args.in[6];
    F.g_mix_pre = args.in[7]; F.g_mix_post = args.in[8]; F.g_ffn_pre = args.in[9]; F.g_ffn_post = args.in[10]; F.w_in = args.in[11]; F.w_pool = args.in[12]; F.pscale = args.in[13];
    F.convw = args.in[14]; F.convb = args.in[15]; F.wa = args.in[16]; F.ba = args.in[17]; F.wx = args.in[18]; F.bx = args.in[19]; F.lam = args.in[20];
    F.w_out = args.in[21]; F.w_fi = args.in[22]; F.w_fo = args.in[23];
    F.out = args.out; F.newstate = args.out + (size_t)M * D;
    F.MOD = (float*)(ws + WS_MOD);
    F.Win_t = (bf16*)(ws + WS_WIN); F.Wout_t = (bf16*)(ws + WS_WOUT); F.Wfi_t = (bf16*)(ws + WS_WFI); F.Wfo_t = (bf16*)(ws + WS_WFO); F.Wcat = (bf16*)(ws + WS_WCAT); F.Wpt = (bf16*)(ws + WS_WPT);
    F.LSC = (float*)(ws + WS_LSC); F.CAGG = (f32x2*)(ws + WS_CAGG);
    F.XN = (bf16*)(ws + WS_XN); F.MIX = (bf16*)(ws + WS_XN); F.H2 = (bf16*)(ws + WS_XN); F.FF = (float*)(ws + WS_XN);
    F.U = (bf16*)(ws + WS_U); F.MIXO = (float*)(ws + WS_U); F.ACT = (bf16*)(ws + WS_ACT);
    for (int u = F.tid; u < (LDS_BYTES - MISC_OFF) / 4; u += NWAVES * 64) ((LAS unsigned*)(F.lds + MISC_OFF))[u] = 0u;
    __syncthreads();
    const int lo = args.ph_lo, hi = args.ph_hi;
    XcdBarrier bar; bar.bar = (unsigned*)(F.ctl + CW_BAR); bar.x = 0; bar.st = nullptr;
    if (hi - lo > 1) bar = xcd_barrier_post((unsigned*)(F.ctl + CW_BAR), F.MISC + 8);
#ifndef PH_MASK
#define PH_MASK 0x3ff
#endif
#define IN(k) (((PH_MASK >> (k)) & 1) && lo <= (k) && (k) < hi)
#define SEAM(k) do { if (IN(k) && IN((k) + 1)) xcd_barrier(bar); } while (0)

    if (IN(0)) { p0_prologue(F); } SEAM(0);
    if (IN(1)) { p1_xn(F); } SEAM(1);
    if (IN(2)) {
        pg8::Gemm g{F.XN, F.Win_t, M, NIN, D}; pg8::StaticOrder S; S.init(M, NIN, F.G, (int)blockIdx.x);
        pg8::EpiBf16<0> E{F.U, NIN, nullptr, 0, 0, 1.f};
        pg8::gemm_phase<pg8::EpiBf16<0>, pg8::StaticOrder, true, true>(F.lds + RING_OFF, g, S, E);
    } SEAM(2);
    if (IN(3)) {
        for (int u = F.vcu; u < NCH_S * 2 * NHEAD + (M / 128) * 4; u += F.G) {
            if (u < NCH_S * 2 * NHEAD) lru_unit<false>(F, NCH_P + u / (2 * NHEAD), u % (2 * NHEAD));
            else { const int v = u - NCH_S * 2 * NHEAD; pool_unit(F, v >> 2, v & 3); } }
    } SEAM(3);
    if (IN(4)) {
        for (int u = F.vcu; u < NCH * 2 * NHEAD; u += F.G) lru_unit<true>(F, u / (2 * NHEAD), u % (2 * NHEAD));
    } SEAM(4);
    if (IN(5)) {
        pg8::Gemm g{F.MIX, F.Wout_t, M, D, D}; pg8::StaticOrder S; S.init(M, D, F.G, (int)blockIdx.x);
        pg8::EpiF32 E{F.MIXO, D};
        pg8::gemm_phase<pg8::EpiF32, pg8::StaticOrder, true, true>(F.lds + RING_OFF, g, S, E);
    } SEAM(5);
    if (IN(6)) { p6_rows(F); } SEAM(6);
    if (IN(7)) {
        pg8::Gemm g{F.H2, F.Wfi_t, M, 2 * DFF, D}; pg8::StaticOrder S; S.init(M, 2 * DFF, F.G, (int)blockIdx.x);
        pg8::EpiSwiglu E{F.ACT, DFF};
        pg8::gemm_phase<pg8::EpiSwiglu, pg8::StaticOrder, true, true>(F.lds + RING_OFF, g, S, E);
    } SEAM(7);
    if (IN(8)) {
        pg8::Gemm g{F.ACT, F.Wfo_t, M, D, DFF}; pg8::StaticOrder S; S.init(M, D, F.G, (int)blockIdx.x);
        pg8::EpiF32 E{F.FF, D};
        pg8::gemm_phase<pg8::EpiF32, pg8::StaticOrder, true, true>(F.lds + RING_OFF, g, S, E);
    } SEAM(8);
    if (IN(9)) { p9_rows(F); }
#undef IN
#undef SEAM
}

extern "C" void kernel_launch(void* const* d_in, const int* in_sizes, int n_in, void* d_out, int out_size, void* d_ws, size_t ws_size, hipStream_t stream) {
    static int grid = 0;
    if (grid == 0) {
        if (n_in != 24 || in_sizes[0] != MP * D || in_sizes[1] != MS * D || out_size != M * D + NB * 2 * LW || ws_size < WS_END) {
            fprintf(stderr, "kernel_launch: unexpected shapes: n_in %d, in0 %d, in1 %d, out %d, ws %zu; nothing launched\n", n_in, n_in > 0 ? in_sizes[0] : -1, n_in > 1 ? in_sizes[1] : -1, out_size, ws_size); grid = -1; return; }
        int dev = 0, cus = 0, per_cu = 0;
        if (hipGetDevice(&dev) != hipSuccess || hipDeviceGetAttribute(&cus, hipDeviceAttributeMultiprocessorCount, dev) != hipSuccess) { fprintf(stderr, "kernel_launch: device query failed\n"); grid = -1; return; }
        if (hipFuncSetAttribute((const void*)mega_fwd, hipFuncAttributeMaxDynamicSharedMemorySize, LDS_BYTES) != hipSuccess) { fprintf(stderr, "kernel_launch: hipFuncSetAttribute failed\n"); grid = -1; return; }
        if (hipOccupancyMaxActiveBlocksPerMultiprocessor(&per_cu, (const void*)mega_fwd, NWAVES * 64, LDS_BYTES) != hipSuccess || per_cu < 1) {
            fprintf(stderr, "kernel_launch: occupancy query reports %d workgroups per CU: the grid cannot be resident; nothing launched\n", per_cu); (void)hipGetLastError(); grid = -1; return; }
        grid = cus;
    }
    if (grid < 0) return;
    if (hipMemsetAsync((char*)d_ws + WS_CTL, 0, CTL_ZERO_BYTES, stream) != hipSuccess) { fprintf(stderr, "kernel_launch: hipMemsetAsync failed\n"); return; }
    Args a{};
    for (int i = 0; i < 24; ++i) a.in[i] = (const float*)d_in[i];
    a.out = (float*)d_out; a.ws = (unsigned char*)d_ws;
#if MK_ONE_LAUNCH
    a.ph_lo = 0; a.ph_hi = N_PHASES;
    hipLaunchKernelGGL(mega_fwd, dim3(grid), dim3(NWAVES * 64), LDS_BYTES, stream, a);
#else
    for (int p = 0; p < N_PHASES; ++p) { a.ph_lo = p; a.ph_hi = p + 1; hipLaunchKernelGGL(mega_fwd, dim3(grid), dim3(NWAVES * 64), LDS_BYTES, stream, a); }
#endif
    const hipError_t le = hipPeekAtLastError();
    if (le != hipSuccess) fprintf(stderr, "kernel_launch: launch failed: %s (grid %d x %d threads, %d B LDS)\n", hipGetErrorName(le), grid, NWAVES * 64, LDS_BYTES);
}
```

```cpp
#include <hip/hip_runtime.h>
#include <cstdio>
#include <cstdint>
namespace pg8 {
#define PG8_LAS __attribute__((address_space(3)))
typedef unsigned short bf16_t;
typedef short bf16x8 __attribute__((ext_vector_type(8)));
typedef float f32x4 __attribute__((ext_vector_type(4)));
typedef unsigned u32x4 __attribute__((ext_vector_type(4)));
constexpr int BM = 256, BK = 64, HALF = 128, HTB = HALF * BK * 2  , STAGE_BYTES = 8 * HTB, NXCD = 8, WGM = 8;

__host__ __device__ __forceinline__ int lds_byte(int r, int c) { const int st = (r >> 4) * 2 + (c >> 5), rr = r & 15, cc = c & 31, ob = rr * 64 + cc * 2; return st * 1024 + (ob ^ (((ob >> 9) & 1) << 5)); }
__host__ __device__ __forceinline__ void stage_rc(int b, int& R, int& C) { const int st = b / 1024, sb = b % 1024, swz = sb ^ (((sb >> 9) & 1) << 5); R = (st >> 1) * 16 + swz / 64; C = (st & 1) * 32 + (swz % 64) / 2; }
__host__ __device__ __forceinline__ int perm32(int rho) { const int n = rho >> 4, i = rho & 15; return 8 * (i >> 2) + 4 * n + (i & 3); }

struct Unit { int pm, pn; };
struct Gemm { const bf16_t* A; const bf16_t* Bt; int M, N, K; };

struct StaticOrder {
    int nM, nN, nwg, G, c;
    __host__ __device__ void init(int M, int N, int G_, int c_) { nM = M / BM; nN = N / BM; nwg = nM * nN; G = G_; c = c_; }
    __host__ __device__ bool next(int i, Unit& u) const {
        const long L = (long)i * G + c; if (L >= nwg) return false;
        int wgid = (int)L; { const int q = nwg / NXCD, r = nwg % NXCD, xcd = wgid % NXCD, off = wgid / NXCD; wgid = (xcd < r ? xcd * (q + 1) : r * (q + 1) + (xcd - r) * q) + off; }
        const int nig = WGM * nN, gid = wgid / nig, fm = gid * WGM, gsz = (nM - fm) < WGM ? (nM - fm) : WGM;
        u.pm = fm + ((wgid % nig) % gsz); u.pn = (wgid % nig) / gsz; return true;
    }
    __device__ __forceinline__ void a_ready(const Unit&) const {}
    __device__ __forceinline__ void done(const Unit&) const {}
};

__device__ __forceinline__ unsigned cvt_pk_bf16(float lo, float hi) { unsigned r; asm volatile("v_cvt_pk_bf16_f32 %0, %1, %2" : "=v"(r) : "v"(lo), "v"(hi)); return r; }
typedef float f32x2 __attribute__((ext_vector_type(2)));
__device__ __forceinline__ f32x2 gelu_pk(f32x2 v) {
    const f32x2 av = __builtin_elementwise_abs(v), d = av * 0.2316418882f + 1.0f;
    f32x2 t; t.x = __builtin_amdgcn_rcpf(d.x); t.y = __builtin_amdgcn_rcpf(d.y);
    f32x2 q = t * 0.5307027145f + (-0.7265760135f); q = q * t + 0.7107068705f; q = q * t + (-0.142248368f); q = q * t + 0.127414796f; q = q * t;
    const f32x2 s = (v * v) * (-0.72134752044f);
    f32x2 e; e.x = __builtin_amdgcn_exp2f(s.x); e.y = __builtin_amdgcn_exp2f(s.y);
    const f32x2 m = v * (q * e), r = v - m;
    f32x2 o; o.x = v.x < 0.f ? m.x : r.x; o.y = v.y < 0.f ? m.y : r.y; return o;
}

template <int ACT  > struct EpiBf16 {
    static constexpr bool PERM = true, AFTER_DRAIN = false; static_assert(ACT == 0 || ACT == 1, "EpiBf16: ACT is 0 (none) or 1 (gelu_pk)");
    bf16_t* O; int ldc; const float* bias; int split_cols; size_t split_stride; float scale0;
    __device__ __forceinline__ void operator()(const f32x4 (&acc)[2][2][4][2], const Unit& u, int wr, int wc, int fr, int fq) const {
        const int row0 = u.pm * BM + wr * 64 + fr; int colt = u.pn * BM; bf16_t* base = O;
        float sc = 1.f; if (split_cols) { const int t = colt / split_cols; base += (size_t)t * split_stride; colt -= t * split_cols; if (t == 0) sc = scale0; }
        const int col0 = colt + wc * 32 + 8 * fq, bcol0 = u.pn * BM + wc * 32 + 8 * fq;
        f32x4 bv[2][2];
#pragma unroll
        for (int bj = 0; bj < 2; ++bj)
#pragma unroll
            for (int n = 0; n < 2; ++n) bv[bj][n] = bias ? *(const f32x4*)(bias + bcol0 + bj * HALF + 4 * n) : (f32x4){0.f, 0.f, 0.f, 0.f};
#pragma unroll
        for (int ai = 0; ai < 2; ++ai)
#pragma unroll
            for (int m = 0; m < 4; ++m) { bf16_t* rowp = base + (size_t)(row0 + ai * HALF + m * 16) * ldc + col0;
#pragma unroll
                for (int bj = 0; bj < 2; ++bj) { f32x4 v0 = acc[ai][bj][m][0] + bv[bj][0], v1 = acc[ai][bj][m][1] + bv[bj][1];
                    if (ACT == 1) { f32x2 a = gelu_pk((f32x2){v0[0], v0[1]}), b = gelu_pk((f32x2){v0[2], v0[3]}), c = gelu_pk((f32x2){v1[0], v1[1]}), d = gelu_pk((f32x2){v1[2], v1[3]});
                        v0 = (f32x4){a.x, a.y, b.x, b.y}; v1 = (f32x4){c.x, c.y, d.x, d.y}; }
                    v0 = v0 * sc; v1 = v1 * sc; u32x4 w; w.x = cvt_pk_bf16(v0[0], v0[1]); w.y = cvt_pk_bf16(v0[2], v0[3]); w.z = cvt_pk_bf16(v1[0], v1[1]); w.w = cvt_pk_bf16(v1[2], v1[3]);
                    *(u32x4*)(rowp + bj * HALF) = w; } }
    }
};
struct EpiF32 {
    static constexpr bool PERM = false, AFTER_DRAIN = false;
    float* C; int ldc;
    __device__ __forceinline__ void operator()(const f32x4 (&acc)[2][2][4][2], const Unit& u, int wr, int wc, int fr, int fq) const {
        const int row0 = u.pm * BM + wr * 64 + fr, col0 = u.pn * BM + wc * 32 + 4 * fq;
#pragma unroll
        for (int ai = 0; ai < 2; ++ai)
#pragma unroll
            for (int m = 0; m < 4; ++m) { float* rowp = C + (size_t)(row0 + ai * HALF + m * 16) * ldc + col0;
#pragma unroll
                for (int bj = 0; bj < 2; ++bj)
#pragma unroll
                    for (int n = 0; n < 2; ++n) *(f32x4*)(rowp + bj * HALF + n * 16) = acc[ai][bj][m][n]; }
    }
};
struct EpiSwiglu {
    static constexpr bool PERM = true, AFTER_DRAIN = false;
    bf16_t* O; int ldc;
    __device__ __forceinline__ void operator()(const f32x4 (&acc)[2][2][4][2], const Unit& u, int wr, int wc, int fr, int fq) const {
        const int row0 = u.pm * BM + wr * 64 + fr, col0 = u.pn * HALF + wc * 32 + 8 * fq;
#pragma unroll
        for (int ai = 0; ai < 2; ++ai)
#pragma unroll
            for (int m = 0; m < 4; ++m) { bf16_t* rowp = O + (size_t)(row0 + ai * HALF + m * 16) * ldc + col0;
                float o[8];
#pragma unroll
                for (int n = 0; n < 2; ++n)
#pragma unroll
                    for (int e = 0; e < 4; ++e) { const float g = acc[ai][0][m][n][e], up = acc[ai][1][m][n][e];
                        o[4 * n + e] = g * __builtin_amdgcn_rcpf(1.0f + __builtin_amdgcn_exp2f(-1.4426950408889634f * g)) * up; }
                u32x4 w; w.x = cvt_pk_bf16(o[0], o[1]); w.y = cvt_pk_bf16(o[2], o[3]); w.z = cvt_pk_bf16(o[4], o[5]); w.w = cvt_pk_bf16(o[6], o[7]);
                *(u32x4*)rowp = w; }
    }
};

template <class Epi, class Sched, bool ALIGN_EPI = false, bool SP2 = false>
__device__ __forceinline__ void gemm_phase(PG8_LAS unsigned char* lds, const Gemm g, const Sched& S, const Epi& E) {
    const int tid = threadIdx.x, wid = __builtin_amdgcn_readfirstlane(tid >> 6), lane = tid & 63, wr = wid >> 2, wc = wid & 3, fr = lane & 15, fq = lane >> 4;
    const int K = g.K, nt = K / BK;
    unsigned voffA[2], voffB[2];
#pragma unroll
    for (int i = 0; i < 2; ++i) { int R, C; stage_rc(tid * 16 + i * 8192, R, C); const int Rb = Epi::PERM ? ((R & ~31) + perm32(R & 31)) : R;
        voffA[i] = (unsigned)(R * K + C) * 2u; voffB[i] = (unsigned)(Rb * K + C) * 2u; }
    const size_t kstep = (size_t)(BK * 2);
    const size_t hstep = (size_t)HALF * K * 2;
    const size_t tstep = 2 * hstep;
    const unsigned ldsw = (unsigned)wid * 1024u;
    const int aoff = lds_byte(wr * 64 + fr, fq * 8), boff = lds_byte(wc * 32 + fr, fq * 8);
#define PG8_SA(b, h) (((b) * 2 + (h)) * HTB)
#define PG8_SB(b, h) ((4 + (b) * 2 + (h)) * HTB)
#define PG8_STAGE(bufoff, gbase, voff) do { _Pragma("unroll") for (int _i = 0; _i < 2; ++_i) \
        __builtin_amdgcn_global_load_lds((const unsigned*)((const char*)(gbase) + (voff)[_i]), (PG8_LAS unsigned*)(lds + (bufoff) + ldsw + _i * 8192), 16, 0, 0); } while (0)
#define PG8_LDA(dst, b, h) do { _Pragma("unroll") for (int m = 0; m < 4; ++m) _Pragma("unroll") for (int k = 0; k < 2; ++k) dst[m][k] = *(const PG8_LAS bf16x8*)(lds + PG8_SA(b, h) + aoff + m * 2048 + k * 1024); } while (0)
#define PG8_LDB(dst, b, h) do { _Pragma("unroll") for (int n = 0; n < 2; ++n) _Pragma("unroll") for (int k = 0; k < 2; ++k) dst[n][k] = *(const PG8_LAS bf16x8*)(lds + PG8_SB(b, h) + boff + n * 2048 + k * 1024); } while (0)
#define PG8_MMA(ai, bj, At, Bt) do { __builtin_amdgcn_s_setprio(1); _Pragma("unroll") for (int m = 0; m < 4; ++m) _Pragma("unroll") for (int n = 0; n < 2; ++n) _Pragma("unroll") for (int k = 0; k < 2; ++k) \
        acc[ai][bj][m][n] = __builtin_amdgcn_mfma_f32_16x16x32_bf16(Bt[n][k], At[m][k], acc[ai][bj][m][n], 0, 0, 0); __builtin_amdgcn_s_setprio(0); } while (0)
#define PG8_WAIT_V(n) asm volatile("s_waitcnt vmcnt(" #n ")" ::: "memory")
#define PG8_WAIT_L(n) asm volatile("s_waitcnt lgkmcnt(" #n ")" ::: "memory")
#define PG8_BAR __builtin_amdgcn_s_barrier()
#define PG8_SCHED __builtin_amdgcn_sched_barrier(0)
    Unit cur, nxt; int ui = 0;
    if (!S.next(0, cur)) return;
    f32x4 acc[2][2][4][2];
#pragma unroll
    for (int a = 0; a < 2; ++a)
#pragma unroll
        for (int b = 0; b < 2; ++b)
#pragma unroll
            for (int m = 0; m < 4; ++m)
#pragma unroll
                for (int n = 0; n < 2; ++n) acc[a][b][m][n] = (f32x4){0.f, 0.f, 0.f, 0.f};
    bf16x8 At[4][2], B0[2][2], B1[2][2];
    const char* cA = (const char*)g.A + (size_t)cur.pm * tstep; const char* cB = (const char*)g.Bt + (size_t)cur.pn * tstep;
    S.a_ready(cur);
    if constexpr (SP2) {
        PG8_STAGE(PG8_SB(0, 0), cB, voffB); PG8_STAGE(PG8_SB(0, 1), cB + hstep, voffB); PG8_STAGE(PG8_SA(0, 0), cA, voffA); PG8_STAGE(PG8_SA(0, 1), cA + hstep, voffA);
        if (wr == 1) PG8_BAR;
        PG8_WAIT_V(2); PG8_BAR;
        PG8_STAGE(PG8_SB(1, 0), cB + kstep, voffB); PG8_STAGE(PG8_SA(1, 0), cA + kstep, voffA); PG8_STAGE(PG8_SB(1, 1), cB + hstep + kstep, voffB);
        PG8_WAIT_V(6); PG8_BAR;
    } else {
        PG8_STAGE(PG8_SB(0, 0), cB, voffB); PG8_STAGE(PG8_SA(0, 0), cA, voffA); PG8_STAGE(PG8_SB(0, 1), cB + hstep, voffB); PG8_STAGE(PG8_SA(0, 1), cA + hstep, voffA);
        if (wr == 1) PG8_BAR;
        PG8_WAIT_V(4); PG8_BAR;
        PG8_STAGE(PG8_SB(1, 0), cB + kstep, voffB); PG8_STAGE(PG8_SA(1, 0), cA + kstep, voffA); PG8_STAGE(PG8_SB(1, 1), cB + hstep + kstep, voffB);
        PG8_WAIT_V(6); PG8_BAR;
    }
    for (;;) {
        const bool has_next = S.next(ui + 1, nxt);
        const char* nA = has_next ? (const char*)g.A + (size_t)nxt.pm * tstep : cA; const char* nB = has_next ? (const char*)g.Bt + (size_t)nxt.pn * tstep : cB;
        for (int t = 0; t < nt; t += 2) {
            const bool last = (t == nt - 2);
            const char* a1 = cA + (size_t)(t + 1) * kstep;
            const char* a2 = last ? nA : cA + (size_t)(t + 2) * kstep; const char* b2 = last ? nB : cB + (size_t)(t + 2) * kstep;
            const char* a3 = a2 + kstep; const char* b3 = b2 + kstep;
            if (last && has_next) S.a_ready(nxt);
            if constexpr (SP2) {
            PG8_LDB(B0, 0, 0); PG8_LDB(B1, 0, 1); PG8_SCHED; PG8_LDA(At, 0, 0); PG8_STAGE(PG8_SA(1, 1), a1 + hstep, voffA);
            PG8_WAIT_V(8); PG8_WAIT_L(0); PG8_BAR; PG8_MMA(0, 0, At, B0); PG8_MMA(0, 1, At, B1); PG8_BAR; PG8_SCHED;
            PG8_LDA(At, 0, 1); PG8_STAGE(PG8_SB(0, 0), b2, voffB); PG8_STAGE(PG8_SB(0, 1), b2 + hstep, voffB); PG8_STAGE(PG8_SA(0, 0), a2, voffA);
            PG8_WAIT_V(8); PG8_WAIT_L(0); PG8_BAR; PG8_MMA(1, 0, At, B0); PG8_MMA(1, 1, At, B1); PG8_BAR; PG8_SCHED;
            PG8_LDB(B0, 1, 0); PG8_LDB(B1, 1, 1); PG8_SCHED; PG8_LDA(At, 1, 0); PG8_STAGE(PG8_SA(0, 1), a2 + hstep, voffA);
            PG8_WAIT_V(8); PG8_WAIT_L(0); PG8_BAR; PG8_MMA(0, 0, At, B0); PG8_MMA(0, 1, At, B1); PG8_BAR; PG8_SCHED;
            PG8_LDA(At, 1, 1); PG8_STAGE(PG8_SB(1, 0), b3, voffB); PG8_STAGE(PG8_SB(1, 1), b3 + hstep, voffB); PG8_STAGE(PG8_SA(1, 0), a3, voffA);
            PG8_WAIT_V(8); PG8_WAIT_L(0); PG8_BAR; PG8_MMA(1, 0, At, B0); PG8_MMA(1, 1, At, B1); PG8_BAR; PG8_SCHED;
            } else {
            PG8_LDB(B0, 0, 0); PG8_SCHED; PG8_LDA(At, 0, 0); PG8_STAGE(PG8_SA(1, 1), a1 + hstep, voffA);
            PG8_WAIT_L(8); PG8_BAR; PG8_WAIT_L(0); PG8_MMA(0, 0, At, B0); PG8_BAR; PG8_SCHED;
            PG8_LDB(B1, 0, 1); PG8_STAGE(PG8_SB(0, 0), b2, voffB);
            PG8_BAR; PG8_WAIT_L(0); PG8_MMA(0, 1, At, B1); PG8_BAR;
            PG8_LDA(At, 0, 1); PG8_STAGE(PG8_SA(0, 0), a2, voffA);
            PG8_BAR; PG8_WAIT_L(0); PG8_MMA(1, 0, At, B0); PG8_BAR; PG8_SCHED;
            PG8_STAGE(PG8_SB(0, 1), b2 + hstep, voffB);
            PG8_WAIT_V(6); PG8_BAR; PG8_MMA(1, 1, At, B1); PG8_BAR;
            PG8_LDB(B0, 1, 0); PG8_SCHED; PG8_LDA(At, 1, 0); PG8_STAGE(PG8_SA(0, 1), a2 + hstep, voffA);
            PG8_WAIT_L(8); PG8_BAR; PG8_WAIT_L(0); PG8_MMA(0, 0, At, B0); PG8_BAR; PG8_SCHED;
            PG8_LDB(B1, 1, 1); PG8_STAGE(PG8_SB(1, 0), b3, voffB);
            PG8_BAR; PG8_WAIT_L(0); PG8_MMA(0, 1, At, B1); PG8_BAR;
            PG8_LDA(At, 1, 1); PG8_STAGE(PG8_SA(1, 0), a3, voffA);
            PG8_BAR; PG8_WAIT_L(0); PG8_MMA(1, 0, At, B0); PG8_BAR; PG8_SCHED;
            PG8_STAGE(PG8_SB(1, 1), b3 + hstep, voffB);
            PG8_WAIT_V(6); PG8_BAR; PG8_MMA(1, 1, At, B1); PG8_BAR;
            }
        }
        if constexpr (ALIGN_EPI) { if (wr == 0) PG8_BAR; }
        if constexpr (!Epi::AFTER_DRAIN) { E(acc, cur, wr, wc, fr, fq); S.done(cur); }
        if (!has_next) break;
#pragma unroll
        for (int a = 0; a < 2; ++a)
#pragma unroll
            for (int b = 0; b < 2; ++b)
#pragma unroll
                for (int m = 0; m < 4; ++m)
#pragma unroll
                    for (int n = 0; n < 2; ++n) acc[a][b][m][n] = (f32x4){0.f, 0.f, 0.f, 0.f};
        cur = nxt; cA = nA; cB = nB; ++ui;
        if constexpr (ALIGN_EPI) { if (wr == 1) PG8_BAR; }
    }
    PG8_WAIT_V(0);
    if constexpr (!ALIGN_EPI) { if (wr == 0) PG8_BAR; }
    PG8_BAR;
    if constexpr (Epi::AFTER_DRAIN) { E.fused(acc, cur, wr, wc, fr, fq, lds, wid, lane); S.done(cur); }
#undef PG8_SA
#undef PG8_SB
#undef PG8_STAGE
#undef PG8_LDA
#undef PG8_LDB
#undef PG8_MMA
#undef PG8_WAIT_V
#undef PG8_WAIT_L
#undef PG8_BAR
#undef PG8_SCHED
}
}

constexpr int NWAVES = 8;
#ifndef MK_ONE_LAUNCH
#define MK_ONE_LAUNCH 1
#endif
constexpr int N_PHASES = 10;

constexpr int D = 1024, NB = 32, SEQ = 256, DB = 4, DSEQ = 4096, GRIDW = 64;
constexpr int MP = NB * SEQ, MS = DB * DSEQ, M = MP + MS;
constexpr int NIN = 1536, PW = 512, LW = 512, DFF = 2816, NMOD = 6 * D, NHEAD = 8, HD = 64;
constexpr int NCH = M / 256, NCH_P = MP / 256, NCH_S = MS / 256;
constexpr float EPS = 1e-6f;

constexpr size_t MiB = 1u << 20, KiB = 1u << 10;
constexpr size_t WS_CTL = 0, CTL_ZERO_BYTES = 1 * MiB;
constexpr size_t WS_MOD = 64 * KiB;
constexpr size_t WS_WIN = 1 * MiB, WS_WOUT = 4 * MiB, WS_WFI = 6 * MiB, WS_WFO = 17 * MiB;
constexpr size_t WS_WCAT = 23 * MiB, WS_WPT = WS_WCAT + 256 * KiB, WS_LSC = WS_WPT + 128 * KiB, WS_CAGG = WS_WCAT + 512 * KiB;
constexpr size_t WS_XN = 24 * MiB;
constexpr size_t WS_U = 72 * MiB;
constexpr size_t WS_FF = 72 * MiB;
constexpr size_t WS_ACT = 124 * MiB;
constexpr size_t WS_END = 256 * MiB;
static_assert(WS_WFO + (size_t)D * DFF * 2 <= WS_WCAT && WS_CAGG + (size_t)NCH_S * 2 * LW * 8 <= WS_XN && WS_ACT + (size_t)M * DFF * 2 <= WS_END && WS_MOD + 5 * NMOD * 4 <= CTL_ZERO_BYTES, "d_ws map");
constexpr int CW_BAR = 4096;

constexpr int LDS_BYTES = 147456;
constexpr int MISC_OFF = LDS_BYTES - 256;
constexpr int RING_OFF = 0;

#define GAS __attribute__((address_space(1)))
#define LAS __attribute__((address_space(3)))
typedef unsigned short bf16;
typedef unsigned v4u __attribute__((ext_vector_type(4)));
typedef unsigned v2u __attribute__((ext_vector_type(2)));
typedef float f32x4 __attribute__((ext_vector_type(4)));
typedef float f32x2 __attribute__((ext_vector_type(2)));
typedef short bf16x8 __attribute__((ext_vector_type(8)));
typedef GAS unsigned gu32;
typedef GAS unsigned long long gu64;
#define RLX_AGENT __ATOMIC_RELAXED, __HIP_MEMORY_SCOPE_AGENT
#define LDS_WAIT() asm volatile("s_waitcnt lgkmcnt(0)" ::: "memory")
#define VM_WAIT() asm volatile("s_waitcnt vmcnt(0)" ::: "memory")
__device__ __forceinline__ unsigned f2bf(float f) { unsigned u = __builtin_bit_cast(unsigned, f); return (u + 0x7fffu + ((u >> 16) & 1u)) >> 16; }
__device__ __forceinline__ unsigned pk2(float lo, float hi) { return f2bf(lo) | (f2bf(hi) << 16); }
__device__ __forceinline__ float bflo(unsigned w) { return __builtin_bit_cast(float, w << 16); }
__device__ __forceinline__ float bfhi(unsigned w) { return __builtin_bit_cast(float, w & 0xffff0000u); }
__device__ __forceinline__ float fsigmoid(float z) { return __builtin_amdgcn_rcpf(1.0f + __builtin_amdgcn_exp2f(-1.4426950408889634f * z)); }

#define XB_TMO      128
#define XB_XCNT(j)  (256  + 64 * (j))
#define XB_XSUB(j)  (1280 + 64 * (j))
#define XB_XGEN(j)  (2304 + 64 * (j))
#define XB_TOP      3328
#define XB_TOPGEN   3392
#define XCD_BAR_WORDS 3456
#define XB_SPIN_CAP (1u << 18)

__device__ __forceinline__ unsigned xb_ld(unsigned* p)              { return __hip_atomic_load(p, __ATOMIC_RELAXED, __HIP_MEMORY_SCOPE_AGENT); }
__device__ __forceinline__ unsigned xb_add(unsigned* p, unsigned v) { return __hip_atomic_fetch_add(p, v, __ATOMIC_RELAXED, __HIP_MEMORY_SCOPE_AGENT); }
__device__ __forceinline__ unsigned xb_xcc_id() { return (unsigned)__builtin_amdgcn_s_getreg((3 << 11) | 20) & 0xFu; }
#define XB_SPIN(cond, bar) do { unsigned _sp = 0; while (cond) { __builtin_amdgcn_s_sleep(1); \
    if ((++_sp & 255u) == 0u) { if (xb_ld(&(bar)[XB_TMO])) break; if (_sp > XB_SPIN_CAP) { atomicAdd(&(bar)[XB_TMO], 1u); break; } } } } while (0)

struct XcdBarrier {
    unsigned* bar; unsigned x;
    volatile LAS unsigned* st;
};

__device__ __forceinline__ XcdBarrier xcd_barrier_post(unsigned* bar, volatile LAS unsigned* st) {
    XcdBarrier b; b.bar = bar; b.x = xb_xcc_id(); b.st = st;
    if (threadIdx.x == 0) (void)xb_add(&bar[XB_XCNT(b.x)], 1u);
    return b;
}
__device__ __forceinline__ void xcd_barrier_complete(unsigned* bar, unsigned x, unsigned& nloc, unsigned& nx) {
    const unsigned G = gridDim.x * gridDim.y * gridDim.z;
    unsigned sum, cnt, mine, sp = 0u;
    for (;;) {
        sum = 0u; cnt = 0u; mine = 0u;
#pragma unroll
        for (unsigned j = 0; j < 16; ++j) { const unsigned c = xb_ld(&bar[XB_XCNT(j)]); sum += c; cnt += (c > 0u) ? 1u : 0u; mine = (j == x) ? c : mine; }
        if (sum == G) break;
        __builtin_amdgcn_s_sleep(1);
        if ((++sp & 255u) == 0u) { if (xb_ld(&bar[XB_TMO])) break; if (sp > XB_SPIN_CAP) { atomicAdd(&bar[XB_TMO], 1u); break; } }
    }
    nloc = mine > 0u ? mine : 1u; nx = cnt > 0u ? cnt : 1u;
}

__device__ __forceinline__ void xcd_barrier(const XcdBarrier& b) {
    asm volatile("s_waitcnt vmcnt(0)" ::: "memory");
    __syncthreads();
    if (threadIdx.x == 0) {
        unsigned* bar = b.bar;
        __builtin_amdgcn_s_waitcnt(0);
        unsigned nloc = b.st[0], nx = b.st[1];
        if (nloc == 0u) { xcd_barrier_complete(bar, b.x, nloc, nx); b.st[0] = nloc; b.st[1] = nx; }
        const unsigned old = xb_add(&bar[XB_XSUB(b.x)], 1u);
        const unsigned gen = old / nloc;
        if (old + 1u == (gen + 1u) * nloc) {
            __builtin_amdgcn_fence(__ATOMIC_RELEASE, "agent");
            asm volatile("s_waitcnt vmcnt(0)" ::: "memory");
            const unsigned og = xb_add(&bar[XB_TOP], 1u);
            const unsigned tg = og / nx;
            if (og + 1u == (tg + 1u) * nx) xb_add(&bar[XB_TOPGEN], 1u);
            else XB_SPIN(xb_ld(&bar[XB_TOPGEN]) == tg, bar);
            __builtin_amdgcn_fence(__ATOMIC_ACQUIRE, "agent");
            xb_add(&bar[XB_XGEN(b.x)], 1u);
            asm volatile("s_waitcnt vmcnt(0)" ::: "memory");
        } else {
            XB_SPIN(xb_ld(&bar[XB_XGEN(b.x)]) == gen, bar);
            __builtin_amdgcn_fence(__ATOMIC_ACQUIRE, "agent");
            asm volatile("s_waitcnt vmcnt(0)" ::: "memory");
        }
    }
    __syncthreads();
}

struct Frame {
    LAS unsigned char* lds;
    volatile LAS unsigned* MISC;
    gu32* ctl;
    int tid, lane, wave;
    int vcu, G;
    const float *xp, *xs, *c, *state, *cctx, *wmod, *bmod, *g_mix_pre, *g_mix_post, *g_ffn_pre, *g_ffn_post, *w_in, *w_pool, *pscale, *convw, *convb, *wa, *ba, *wx, *bx, *lam, *w_out, *w_fi, *w_fo;
    float* out; float* newstate;
    float* MOD;
    bf16 *Win_t, *Wout_t, *Wfi_t, *Wfo_t, *Wcat, *Wpt;
    float* LSC;
    f32x2* CAGG;
    bf16 *XN, *U, *MIX, *H2, *ACT;
    bf16 *MIXO, *FF;
};
__device__ __forceinline__ const float* xrow(const Frame& F, int row) { return row < MP ? F.xp + (size_t)row * D : F.xs + (size_t)(row - MP) * D; }
__device__ __forceinline__ int mod_idx(int row) { return row < MP ? 0 : 1 + (row - MP) / DSEQ; }
__device__ __forceinline__ float wave_sum(float v) {
#pragma unroll
    for (int o = 1; o < 64; o <<= 1) v += __shfl_xor(v, o);
    return v;
}

__device__ __forceinline__ void p0_transpose_item(const float* W, int K, int N, bf16* WT, int k0, int n0, int drow0, LAS float* scr, int lane) {
#pragma unroll 8
    for (int i = 0; i < 32; ++i) { const int kk = 2 * i + (lane >> 5); scr[kk * 33 + (lane & 31)] = W[(size_t)(k0 + kk) * N + n0 + (lane & 31)]; }
    LDS_WAIT(); asm volatile("" ::: "memory");
    const int c = lane & 7;
#pragma unroll
    for (int j = 0; j < 4; ++j) { const int n = (lane >> 3) + 8 * j; const LAS float* s = scr + (8 * c) * 33 + n;
        v4u o; o.x = pk2(s[0 * 33], s[1 * 33]); o.y = pk2(s[2 * 33], s[3 * 33]); o.z = pk2(s[4 * 33], s[5 * 33]); o.w = pk2(s[6 * 33], s[7 * 33]);
        *(GAS v4u*)(WT + (size_t)(drow0 + n) * K + k0 + 8 * c) = o; }
    LDS_WAIT(); asm volatile("" ::: "memory");
}
__device__ __forceinline__ void p0_prologue(Frame& F) {
    LAS float* scr = (LAS float*)(F.lds + RING_OFF + F.wave * 16384);
    const int gw = F.vcu * NWAVES + F.wave, NGW = F.G * NWAVES, lane = F.lane;
    constexpr int MOD_UNITS = (NMOD / 64) * (D / 64);
    for (int it = gw; it < MOD_UNITS; it += NGW) {
        const int cg = it % (NMOD / 64), ks = it / (NMOD / 64), col = cg * 64 + lane, k0 = ks * 64;
        float sv[5];
#pragma unroll
        for (int v = 0; v < 5; ++v) { const float x = v == 0 ? F.cctx[k0 + lane] : F.c[(v - 1) * D + k0 + lane]; sv[v] = x * fsigmoid(x); }
        float acc[5] = {0.f, 0.f, 0.f, 0.f, 0.f};
#pragma unroll 16
        for (int kk = 0; kk < 64; ++kk) { const float w = F.wmod[(size_t)(k0 + kk) * NMOD + col];
#pragma unroll
            for (int v = 0; v < 5; ++v) acc[v] += __shfl(sv[v], kk) * w; }
        const float bm = ks == 0 ? F.bmod[col] : 0.f;
#pragma unroll
        for (int v = 0; v < 5; ++v) atomicAdd(F.MOD + v * NMOD + col, acc[v] + bm);
    }
    constexpr int I_IN = (D / 64) * (NIN / 32), I_OUT = (D / 64) * (D / 32), I_FI = (D / 64) * (2 * DFF / 32), I_FO = (DFF / 64) * (D / 32);
    constexpr int NITEMS = I_IN + I_OUT + I_FI + I_FO;
    for (int it = gw; it < NITEMS; it += NGW) {
        int r = it;
        if (r < I_IN) { const int nblk = NIN / 32, kb = r / nblk, nb = r % nblk; p0_transpose_item(F.w_in, D, NIN, F.Win_t, 64 * kb, 32 * nb, 32 * nb, scr, lane); continue; } r -= I_IN;
        if (r < I_OUT) { const int nblk = D / 32, kb = r / nblk, nb = r % nblk; p0_transpose_item(F.w_out, D, D, F.Wout_t, 64 * kb, 32 * nb, 32 * nb, scr, lane); continue; } r -= I_OUT;
        if (r < I_FI) { const int nblk = 2 * DFF / 32, kb = r / nblk, nb = r % nblk, n0 = 32 * nb;
            const int up = n0 >= DFF ? 1 : 0, j0 = n0 - up * DFF, drow0 = 256 * (j0 / 128) + 128 * up + (j0 % 128);
            p0_transpose_item(F.w_fi, D, 2 * DFF, F.Wfi_t, 64 * kb, n0, drow0, scr, lane); continue; } r -= I_FI;
        { const int nblk = D / 32, kb = r / nblk, nb = r % nblk; p0_transpose_item(F.w_fo, DFF, D, F.Wfo_t, 64 * kb, 32 * nb, 32 * nb, scr, lane); }
    }
    const int gt = F.vcu * NWAVES * 64 + F.tid, NGT = F.G * NWAVES * 64;
    for (int e = gt; e < NHEAD * 256 * 64; e += NGT) { const int i = e & 63, col = (e >> 6) & 255, h = e >> 14, type = col >> 6, j = col & 63, d = type >> 1;
        const float* src = (type & 1) ? F.wx : F.wa; F.Wcat[e] = (bf16)f2bf(src[((size_t)(d * NHEAD + h) * 64 + i) * 64 + j]); }
    for (int e = gt; e < 4 * 128 * 128; e += NGT) { const int c = e & 127, dd = (e >> 7) & 127, g = e >> 14; F.Wpt[e] = (bf16)f2bf(F.w_pool[(size_t)(g * 128 + c) * 128 + dd]); }
    for (int e = gt; e < 2 * LW; e += NGT) F.LSC[e] = -8.0f * 1.4426950408889634f * log1pf(expf(-F.lam[e]));
}

__device__ __forceinline__ void p1_xn(Frame& F) {
    const int gw = F.vcu * NWAVES + F.wave, NGW = F.G * NWAVES, lane = F.lane;
    for (int row = gw; row < M; row += NGW) {
        const GAS f32x4* xr = (const GAS f32x4*)xrow(F, row) + lane; const float* mod = F.MOD + mod_idx(row) * NMOD;
        f32x4 v[4]; float s = 0.f;
#pragma unroll
        for (int j = 0; j < 4; ++j) { v[j] = xr[64 * j]; s += (v[j].x * v[j].x + v[j].y * v[j].y) + (v[j].z * v[j].z + v[j].w * v[j].w); }
        const float r = rsqrtf(wave_sum(s) * (1.f / D) + EPS);
        GAS v2u* o8 = (GAS v2u*)(F.XN + (size_t)row * D) + lane;
#pragma unroll
        for (int j = 0; j < 4; ++j) { const int col = 256 * j + 4 * lane;
            const f32x4 g = *(const GAS f32x4*)(F.g_mix_pre + col), sc = *(const GAS f32x4*)(mod + D + col), sh = *(const GAS f32x4*)(mod + col);
            const f32x4 y = v[j] * r * g * (1.0f + sc) + sh; v2u w; w.x = pk2(y.x, y.y); w.y = pk2(y.z, y.w); o8[64 * j] = w; }
    }
}

constexpr int LSTR = 144, UX_OFF = 0, XB_OFF = 37376, AGG_OFF = 74240, CST_OFF = 107008;
static_assert(XB_OFF >= 259 * LSTR && AGG_OFF >= XB_OFF + 256 * LSTR && CST_OFF >= AGG_OFF + 64 * 2 * 32 * 8 && CST_OFF + 64 * 12 * 4 <= MISC_OFF && 128 * LSTR <= 64 * 2 * 32 * 8, "LRU LDS map");
template <bool FULL>
__device__ __forceinline__ void lru_unit(Frame& F, const int ci, const int hh) {
    int tid = F.tid, w = F.wave; asm volatile("" : "+v"(tid)); asm volatile("" : "+s"(w));
    const int lane = tid & 63, fr = lane & 15, fq = lane >> 4, h = hh >> 1, c32 = (hh & 1) * 32;
    LAS unsigned char* lds = F.lds;
    const int row0 = ci * 256; const bool samp = ci >= NCH_P; const int q = samp ? ((ci - NCH_P) & 15) : 0; const bool has_prev = samp && q > 0, has_next = samp && q < 15;
    for (int idx = tid; idx < 259 * 8; idx += NWAVES * 64) { const int rr = idx >> 3, cg = idx & 7, grow = row0 - 2 + rr;
        const bool valid = (rr >= 2 || has_prev) && (rr < 258 || has_next);
        v4u v = {0u, 0u, 0u, 0u}; if (valid) v = *(const GAS v4u*)(F.U + (size_t)grow * NIN + PW + h * HD + cg * 8);
        *(LAS v4u*)(lds + UX_OFF + rr * LSTR + cg * 16) = v; }
#pragma unroll
    for (int it = 0; it < 2; ++it) { const int idx = tid + it * NWAVES * 64, col = idx >> 3, kc = idx & 7, srow = (col >> 5) * 64 + c32 + (col & 31);
        *(LAS v4u*)(lds + AGG_OFF + col * LSTR + kc * 16) = *(const GAS v4u*)(F.Wcat + ((size_t)(h * 256 + srow) * 64 + kc * 8)); }
    if (tid < 64) { const int chh = h * HD + tid; LAS float* c = (LAS float*)(lds + CST_OFF) + tid * 12;
        c[0] = F.convw[chh]; c[1] = F.convw[LW + chh]; c[2] = F.convw[2 * LW + chh]; c[3] = F.convw[3 * LW + chh]; c[4] = F.convb[chh];
        c[5] = F.ba[chh]; c[6] = F.ba[LW + chh]; c[7] = F.bx[chh]; c[8] = F.bx[LW + chh]; c[9] = F.LSC[chh]; c[10] = F.LSC[LW + chh]; c[11] = 0.f; }
    __syncthreads();
    { const int cg = tid & 7; float cw[4][8], cb[8];
#pragma unroll
      for (int e = 0; e < 8; ++e) { const LAS float* c = (const LAS float*)(lds + CST_OFF) + (cg * 8 + e) * 12; cb[e] = c[4];
#pragma unroll
          for (int k = 0; k < 4; ++k) cw[k][e] = c[k]; }
#pragma unroll
      for (int it = 0; it < 4; ++it) { const int t = (tid >> 3) + 64 * it; float xb[8];
#pragma unroll
          for (int e = 0; e < 8; ++e) xb[e] = cb[e];
#pragma unroll
          for (int k = 0; k < 4; ++k) { const v4u v = *(const LAS v4u*)(lds + UX_OFF + (t + k) * LSTR + cg * 16);
              xb[0] += cw[k][0] * bflo(v.x); xb[1] += cw[k][1] * bfhi(v.x); xb[2] += cw[k][2] * bflo(v.y); xb[3] += cw[k][3] * bfhi(v.y);
              xb[4] += cw[k][4] * bflo(v.z); xb[5] += cw[k][5] * bfhi(v.z); xb[6] += cw[k][6] * bflo(v.w); xb[7] += cw[k][7] * bfhi(v.w); }
          v4u o; o.x = pk2(xb[0], xb[1]); o.y = pk2(xb[2], xb[3]); o.z = pk2(xb[4], xb[5]); o.w = pk2(xb[6], xb[7]);
          *(LAS v4u*)(lds + XB_OFF + t * LSTR + cg * 16) = o; } }
    __syncthreads();
    f32x4 acc[2][8];
#pragma unroll
    for (int mt = 0; mt < 2; ++mt)
#pragma unroll
        for (int nt = 0; nt < 8; ++nt) acc[mt][nt] = (f32x4){0.f, 0.f, 0.f, 0.f};
    { bf16x8 a[2][2];
#pragma unroll
      for (int mt = 0; mt < 2; ++mt)
#pragma unroll
          for (int ks = 0; ks < 2; ++ks) a[mt][ks] = *(const LAS bf16x8*)(lds + XB_OFF + (32 * w + 16 * mt + fr) * LSTR + (32 * ks + 8 * fq) * 2);
#pragma unroll
      for (int nt = 0; nt < 8; ++nt)
#pragma unroll
          for (int ks = 0; ks < 2; ++ks) { const bf16x8 b = *(const LAS bf16x8*)(lds + AGG_OFF + (16 * nt + fr) * LSTR + (32 * ks + 8 * fq) * 2);
#pragma unroll
              for (int mt = 0; mt < 2; ++mt) acc[mt][nt] = __builtin_amdgcn_mfma_f32_16x16x32_bf16(a[mt][ks], b, acc[mt][nt], 0, 0, 0); } }
    __syncthreads();
    if constexpr (FULL) {
        const __amdgpu_buffer_rsrc_t ursrc = __builtin_amdgcn_make_buffer_rsrc((void*)F.U, 0, M * NIN * 2, 0x00020000);
        const int voff = ((lane >> 2) * NIN + (lane & 3) * 8) * 2;
#pragma unroll
        for (int it = 0; it < 2; ++it) { const int r16 = (w * 2 + it) * 16;
            __builtin_amdgcn_raw_ptr_buffer_load_lds(ursrc, (LAS unsigned*)(lds + XB_OFF + r16 * 64), 16, voff, ((row0 + r16) * NIN + PW + LW + h * HD + c32) * 2, 0, 0); }
    }
#pragma unroll
    for (int cq = 0; cq < 2; ++cq) { const int ch = c32 + 16 * cq + fr; const LAS float* c = (const LAS float*)(lds + CST_OFF) + ch * 12;
#pragma unroll
        for (int mt = 0; mt < 2; ++mt) { float ux[7], xbf[4];
#pragma unroll
            for (int r = 0; r < 7; ++r) ux[r] = __builtin_bit_cast(float, (unsigned)(*(const LAS unsigned short*)(lds + UX_OFF + (32 * w + 16 * mt + 4 * fq + r) * LSTR + ch * 2)) << 16);
            { const float cw0 = c[0], cw1 = c[1], cw2 = c[2], cw3 = c[3], cbv = c[4];
#pragma unroll
              for (int i = 0; i < 4; ++i) xbf[i] = cbv + cw0 * ux[i] + cw1 * ux[i + 1] + cw2 * ux[i + 2] + cw3 * ux[i + 3]; }
#pragma unroll
            for (int d = 0; d < 2; ++d) { const float bA = c[5 + d], bX = c[7 + d], c8 = c[9 + d];
#pragma unroll
                for (int i = 0; i < 4; ++i) { const float r = fsigmoid(acc[mt][4 * d + cq][i] + bA), ig = fsigmoid(acc[mt][4 * d + 2 + cq][i] + bX);
                    const float a = __builtin_amdgcn_exp2f(r * c8), mult = __builtin_amdgcn_sqrtf(fmaxf(1.0f - a * a, 0.f));
                    acc[mt][4 * d + cq][i] = a; acc[mt][4 * d + 2 + cq][i] = mult * (ig * xbf[i]); } } } }
#pragma unroll
    for (int d = 0; d < 2; ++d)
#pragma unroll
        for (int cq = 0; cq < 2; ++cq)
#pragma unroll
            for (int mt = 0; mt < 2; ++mt) { const f32x4 a = acc[mt][4 * d + cq], b = acc[mt][4 * d + 2 + cq];
                const float A = (a[0] * a[1]) * (a[2] * a[3]);
                const float B = d == 0 ? ((b[0] * a[1] + b[1]) * a[2] + b[2]) * a[3] + b[3] : ((b[3] * a[2] + b[2]) * a[1] + b[1]) * a[0] + b[0];
                *(LAS f32x2*)(lds + AGG_OFF + (((8 * w + 4 * mt + fq) * 2 + d) * 32 + 16 * cq + fr) * 8) = (f32x2){A, B}; }
    if constexpr (FULL) asm volatile("s_waitcnt vmcnt(0)" ::: "memory");
    __syncthreads();
    if (tid < 64) { const int d = tid >> 5, cl = tid & 31, chh = h * HD + c32 + cl;
        if constexpr (FULL) {
            float hc = 0.f;
            if (samp) { const int b = (ci - NCH_P) >> 4; hc = F.state[(b * 2 + d) * LW + chh]; const f32x2* cg = F.CAGG + ((size_t)(b * 16) * 2 + d) * LW + chh;
                f32x2 tq[16];
#pragma unroll
                for (int qq = 0; qq < 16; ++qq) tq[qq] = cg[(size_t)qq * 2 * LW];
                if (d == 0) {
#pragma unroll
                    for (int qq = 0; qq < 16; ++qq) if (qq < q) hc = tq[qq].x * hc + tq[qq].y; }
                else {
#pragma unroll
                    for (int qq = 15; qq >= 0; --qq) if (qq > q) hc = tq[qq].x * hc + tq[qq].y; } }
#pragma unroll 8
            for (int s = 0; s < 64; ++s) { const int g = d == 0 ? s : 63 - s; LAS f32x2* p = (LAS f32x2*)(lds + AGG_OFF + ((g * 2 + d) * 32 + cl) * 8);
                const f32x2 t = *p; *(LAS float*)p = hc; hc = t.x * hc + t.y; }
            if (!samp) F.newstate[(ci * 2 + d) * LW + chh] = hc;
        } else {
            float P = 1.f, Bc = 0.f;
#pragma unroll 8
            for (int s = 0; s < 64; ++s) { const int g = d == 0 ? s : 63 - s; const f32x2 t = *(const LAS f32x2*)(lds + AGG_OFF + ((g * 2 + d) * 32 + cl) * 8);
                Bc = t.x * Bc + t.y; P *= t.x; }
            F.CAGG[((size_t)(ci - NCH_P) * 2 + d) * LW + chh] = (f32x2){P, Bc};
        } }
    if constexpr (FULL) {
        __syncthreads();
#pragma unroll
        for (int cq = 0; cq < 2; ++cq) { const int cl = 16 * cq + fr, chh = h * HD + c32 + cl;
#pragma unroll
            for (int mt = 0; mt < 2; ++mt) { const int g = 8 * w + 4 * mt + fq;
                const f32x4 a0 = acc[mt][cq], b0 = acc[mt][2 + cq], a1 = acc[mt][4 + cq], b1 = acc[mt][6 + cq];
                float hf = *(const LAS float*)(lds + AGG_OFF + ((g * 2 + 0) * 32 + cl) * 8), hb = *(const LAS float*)(lds + AGG_OFF + ((g * 2 + 1) * 32 + cl) * 8);
                float y[4];
#pragma unroll
                for (int i = 0; i < 4; ++i) { hf = a0[i] * hf + b0[i]; y[i] = hf; }
#pragma unroll
                for (int i = 3; i >= 0; --i) { hb = a1[i] * hb + b1[i]; y[i] += hb; }
#pragma unroll
                for (int i = 0; i < 4; ++i) { const int t = 32 * w + 16 * mt + 4 * fq + i;
                    const float x = __builtin_bit_cast(float, (unsigned)(*(const LAS unsigned short*)(lds + XB_OFF + t * 64 + cl * 2)) << 16);
                    const float ge = x * fsigmoid(1.5957691216057308f * (x + 0.044715f * x * x * x));
                    F.MIX[(size_t)(row0 + t) * D + PW + chh] = (bf16)f2bf(y[i] * ge); } } }
    }
    __syncthreads();
}

constexpr int UP_OFF = 0, UP_STRIDE = 256, PM_OFF = 36864, PM_STRIDE = 272;
static_assert(PM_OFF >= 144 * UP_STRIDE && PM_OFF + 128 * PM_STRIDE <= MISC_OFF, "pool LDS map");
__device__ __forceinline__ void pool_unit(Frame& F, const int blk, const int g) {
    int tid = F.tid, w = F.wave; asm volatile("" : "+v"(tid)); asm volatile("" : "+s"(w));
    const int lane = tid & 63, fr = lane & 15, fq = lane >> 4;
    LAS unsigned char* lds = F.lds;
    const int row0 = blk * 128, win = 2 << g, left = win / 2, right = win - 1 - left, segl = row0 < MP ? SEQ : GRIDW;
    for (int idx = tid; idx < 144 * 16; idx += NWAVES * 64) { const int rr = idx >> 4, cg = idx & 15, grow = row0 - 8 + rr;
        if (grow >= 0 && grow < M) *(LAS v4u*)(lds + UP_OFF + rr * UP_STRIDE + cg * 16) = *(const GAS v4u*)(F.U + (size_t)grow * NIN + g * 128 + cg * 8); }
    __syncthreads();
#pragma unroll
    for (int it = 0; it < 4; ++it) { const int idx = tid + it * NWAVES * 64, t = idx >> 4, cg = idx & 15, row = row0 + t;
        const int tl = row < MP ? (row & (SEQ - 1)) : ((row - MP) & (GRIDW - 1)), lo = max(tl - left, 0), hi = min(tl + right + 1, segl);
        const int rbase = t + 8 - tl;
        float s[8] = {0.f, 0.f, 0.f, 0.f, 0.f, 0.f, 0.f, 0.f};
        for (int p = lo; p < hi; ++p) { const v4u v = *(const LAS v4u*)(lds + UP_OFF + (rbase + p) * UP_STRIDE + cg * 16);
            s[0] += bflo(v.x); s[1] += bfhi(v.x); s[2] += bflo(v.y); s[3] += bfhi(v.y); s[4] += bflo(v.z); s[5] += bfhi(v.z); s[6] += bflo(v.w); s[7] += bfhi(v.w); }
        const float inv = 1.0f / (float)(hi - lo);
        const v4u sv = *(const LAS v4u*)(lds + UP_OFF + (t + 8) * UP_STRIDE + cg * 16);
        v4u o; o.x = pk2(s[0] * inv - bflo(sv.x), s[1] * inv - bfhi(sv.x)); o.y = pk2(s[2] * inv - bflo(sv.y), s[3] * inv - bfhi(sv.y));
        o.z = pk2(s[4] * inv - bflo(sv.z), s[5] * inv - bfhi(sv.z)); o.w = pk2(s[6] * inv - bflo(sv.w), s[7] * inv - bfhi(sv.w));
        *(LAS v4u*)(lds + PM_OFF + t * PM_STRIDE + cg * 16) = o; }
    __syncthreads();
    f32x4 acc[8];
#pragma unroll
    for (int nt = 0; nt < 8; ++nt) acc[nt] = (f32x4){0.f, 0.f, 0.f, 0.f};
    { bf16x8 a[4];
#pragma unroll
      for (int ks = 0; ks < 4; ++ks) a[ks] = *(const LAS bf16x8*)(lds + PM_OFF + (16 * w + fr) * PM_STRIDE + (32 * ks + 8 * fq) * 2);
      const GAS bf16x8* wb = (const GAS bf16x8*)(F.Wpt + ((size_t)(g * 128 + fr) * 128 + 8 * fq));
#pragma unroll
      for (int nt = 0; nt < 8; ++nt)
#pragma unroll
          for (int ks = 0; ks < 4; ++ks) acc[nt] = __builtin_amdgcn_mfma_f32_16x16x32_bf16(a[ks], wb[nt * 256 + ks * 4], acc[nt], 0, 0, 0); }
#pragma unroll
    for (int nt = 0; nt < 8; ++nt) { const int dcol = g * 128 + 16 * nt + fr; const float ps = F.pscale[dcol];
#pragma unroll
        for (int i = 0; i < 4; ++i) F.MIX[(size_t)(row0 + 16 * w + 4 * fq + i) * D + dcol] = (bf16)f2bf(acc[nt][i] * ps); }
    __syncthreads();
}

__device__ __forceinline__ void p6_rows(Frame& F) {
    const int gw = F.vcu * NWAVES + F.wave, NGW = F.G * NWAVES, lane = F.lane;
    for (int row = gw; row < M; row += NGW) {
        const GAS f32x4* xr = (const GAS f32x4*)xrow(F, row) + lane; const GAS v2u* mr = (const GAS v2u*)(F.MIXO + (size_t)row * D) + lane; const float* mod = F.MOD + mod_idx(row) * NMOD;
        f32x4 v[4], x[4]; float s = 0.f;
#pragma unroll
        for (int j = 0; j < 4; ++j) { const v2u mw = mr[64 * j]; v[j] = (f32x4){bflo(mw.x), bfhi(mw.x), bflo(mw.y), bfhi(mw.y)}; x[j] = xr[64 * j]; s += (v[j].x * v[j].x + v[j].y * v[j].y) + (v[j].z * v[j].z + v[j].w * v[j].w); }
        const float r = rsqrtf(wave_sum(s) * (1.f / D) + EPS); float s2 = 0.f;
#pragma unroll
        for (int j = 0; j < 4; ++j) { const int col = 256 * j + 4 * lane;
            const f32x4 gp = *(const GAS f32x4*)(F.g_mix_post + col), g1 = *(const GAS f32x4*)(mod + 2 * D + col);
            x[j] = x[j] + g1 * (v[j] * r * gp); s2 += (x[j].x * x[j].x + x[j].y * x[j].y) + (x[j].z * x[j].z + x[j].w * x[j].w); }
        const float r2 = rsqrtf(wave_sum(s2) * (1.f / D) + EPS);
        GAS f32x4* o = (GAS f32x4*)(F.out + (size_t)row * D) + lane; GAS v2u* o8 = (GAS v2u*)(F.H2 + (size_t)row * D) + lane;
#pragma unroll
        for (int j = 0; j < 4; ++j) { const int col = 256 * j + 4 * lane; o[64 * j] = x[j];
            const f32x4 g = *(const GAS f32x4*)(F.g_ffn_pre + col), sc = *(const GAS f32x4*)(mod + 4 * D + col), sh = *(const GAS f32x4*)(mod + 3 * D + col);
            const f32x4 y = x[j] * r2 * g * (1.0f + sc) + sh; v2u wv; wv.x = pk2(y.x, y.y); wv.y = pk2(y.z, y.w); o8[64 * j] = wv; }
    }
}
__device__ __forceinline__ void p9_rows(Frame& F) {
    const int gw = F.vcu * NWAVES + F.wave, NGW = F.G * NWAVES, lane = F.lane;
    for (int row = gw; row < M; row += NGW) {
        GAS f32x4* o = (GAS f32x4*)(F.out + (size_t)row * D) + lane; const GAS v2u* fr_ = (const GAS v2u*)(F.FF + (size_t)row * D) + lane; const float* mod = F.MOD + mod_idx(row) * NMOD;
        f32x4 v[4], x[4]; float s = 0.f;
#pragma unroll
        for (int j = 0; j < 4; ++j) { const v2u fw = fr_[64 * j]; v[j] = (f32x4){bflo(fw.x), bfhi(fw.x), bflo(fw.y), bfhi(fw.y)}; x[j] = o[64 * j]; s += (v[j].x * v[j].x + v[j].y * v[j].y) + (v[j].z * v[j].z + v[j].w * v[j].w); }
        const float r = rsqrtf(wave_sum(s) * (1.f / D) + EPS);
#pragma unroll
        for (int j = 0; j < 4; ++j) { const int col = 256 * j + 4 * lane;
            const f32x4 gp = *(const GAS f32x4*)(F.g_ffn_post + col), g2 = *(const GAS f32x4*)(mod + 5 * D + col);
            o[64 * j] = x[j] + g2 * (v[j] * r * gp); }
    }
}

struct Args { const float* in[24]; float* out; unsigned char* ws; int ph_lo, ph_hi; };
static_assert(sizeof(Args) == 26 * 8 + 8, "Args has no padding");
__global__ void __launch_bounds__(NWAVES * 64, 2) mega_fwd(Args args) {
    extern __shared__ __attribute__((aligned(16))) unsigned char lds[];
    Frame F;
    F.lds = (LAS unsigned char*)lds;
    F.MISC = (volatile LAS unsigned*)(F.lds + MISC_OFF);
    F.tid = threadIdx.x; F.lane = F.tid & 63; F.wave = __builtin_amdgcn_readfirstlane(F.tid >> 6);
    F.G = gridDim.x; { const int bx = blockIdx.x; F.vcu = (F.G % 8 == 0) ? (bx % 8) * (F.G / 8) + bx / 8 : bx; }
    unsigned char* ws = args.ws;
    F.ctl = (gu32*)(ws + WS_CTL);
    F.xp = args.in[0]; F.xs = args.in[1]; F.c = args.in[2]; F.state = args.in[3]; F.cctx = args.in[4]; F.wmod = args.in[5]; F.bmod = args.in[6];
    F.g_mix_pre = args.in[7]; F.g_mix_post = args.in[8]; F.g_ffn_pre = args.in[9]; F.g_ffn_post = args.in[10]; F.w_in = args.in[11]; F.w_pool = args.in[12]; F.pscale = args.in[13];
    F.convw = args.in[14]; F.convb = args.in[15]; F.wa = args.in[16]; F.ba = args.in[17]; F.wx = args.in[18]; F.bx = args.in[19]; F.lam = args.in[20];
    F.w_out = args.in[21]; F.w_fi = args.in[22]; F.w_fo = args.in[23];
    F.out = args.out; F.newstate = args.out + (size_t)M * D;
    F.MOD = (float*)(ws + WS_MOD);
    F.Win_t = (bf16*)(ws + WS_WIN); F.Wout_t = (bf16*)(ws + WS_WOUT); F.Wfi_t = (bf16*)(ws + WS_WFI); F.Wfo_t = (bf16*)(ws + WS_WFO); F.Wcat = (bf16*)(ws + WS_WCAT); F.Wpt = (bf16*)(ws + WS_WPT);
    F.LSC = (float*)(ws + WS_LSC); F.CAGG = (f32x2*)(ws + WS_CAGG);
    F.XN = (bf16*)(ws + WS_XN); F.MIX = (bf16*)(ws + WS_XN); F.H2 = (bf16*)(ws + WS_XN); F.FF = (bf16*)(ws + WS_FF);
    F.U = (bf16*)(ws + WS_U); F.MIXO = (bf16*)(ws + WS_U); F.ACT = (bf16*)(ws + WS_ACT);
    for (int u = F.tid; u < (LDS_BYTES - MISC_OFF) / 4; u += NWAVES * 64) ((LAS unsigned*)(F.lds + MISC_OFF))[u] = 0u;
    __syncthreads();
    const int lo = args.ph_lo, hi = args.ph_hi;
    XcdBarrier bar; bar.bar = (unsigned*)(F.ctl + CW_BAR); bar.x = 0; bar.st = nullptr;
    if (hi - lo > 1) bar = xcd_barrier_post((unsigned*)(F.ctl + CW_BAR), F.MISC + 8);
#ifndef PH_MASK
#define PH_MASK 0x3ff
#endif
#define IN(k) (((PH_MASK >> (k)) & 1) && lo <= (k) && (k) < hi)
#define SEAM(k) do { if (IN(k) && IN((k) + 1)) xcd_barrier(bar); } while (0)
#ifndef PROBE_REPEAT
#define PROBE_REPEAT 0
#endif
#define REPS(k) for (int rep_ = 0; rep_ <= ((PROBE_REPEAT >> (k)) & 1); ++rep_, (rep_ <= ((PROBE_REPEAT >> (k)) & 1) ? xcd_barrier(bar) : (void)0))

    if (IN(0)) REPS(0) { p0_prologue(F); } SEAM(0);
    if (IN(1)) REPS(1) { p1_xn(F); } SEAM(1);
    if (IN(2)) REPS(2) {
        pg8::Gemm g{F.XN, F.Win_t, M, NIN, D}; pg8::StaticOrder S; S.init(M, NIN, F.G, (int)blockIdx.x);
        pg8::EpiBf16<0> E{F.U, NIN, nullptr, 0, 0, 1.f};
        pg8::gemm_phase<pg8::EpiBf16<0>, pg8::StaticOrder, true, true>(F.lds + RING_OFF, g, S, E);
    } SEAM(2);
    if (IN(3)) REPS(3) {
        for (int u = F.vcu; u < NCH_S * 2 * NHEAD + (M / 128) * 4; u += F.G) {
            if (u < NCH_S * 2 * NHEAD) lru_unit<false>(F, NCH_P + u / (2 * NHEAD), u % (2 * NHEAD));
            else { const int v = u - NCH_S * 2 * NHEAD; pool_unit(F, v >> 2, v & 3); } }
    } SEAM(3);
    if (IN(4)) REPS(4) {
        for (int u = F.vcu; u < NCH * 2 * NHEAD; u += F.G) lru_unit<true>(F, u / (2 * NHEAD), u % (2 * NHEAD));
    } SEAM(4);
    if (IN(5)) REPS(5) {
        pg8::Gemm g{F.MIX, F.Wout_t, M, D, D}; pg8::StaticOrder S; S.init(M, D, F.G, (int)blockIdx.x);
        pg8::EpiBf16<0> E{F.MIXO, D, nullptr, 0, 0, 1.f};
        pg8::gemm_phase<pg8::EpiBf16<0>, pg8::StaticOrder, true, true>(F.lds + RING_OFF, g, S, E);
    } SEAM(5);
    if (IN(6)) REPS(6) { p6_rows(F); } SEAM(6);
    if (IN(7)) REPS(7) {
        pg8::Gemm g{F.H2, F.Wfi_t, M, 2 * DFF, D}; pg8::StaticOrder S; S.init(M, 2 * DFF, F.G, (int)blockIdx.x);
        pg8::EpiSwiglu E{F.ACT, DFF};
        pg8::gemm_phase<pg8::EpiSwiglu, pg8::StaticOrder, true, true>(F.lds + RING_OFF, g, S, E);
    } SEAM(7);
    if (IN(8)) REPS(8) {
        pg8::Gemm g{F.ACT, F.Wfo_t, M, D, DFF}; pg8::StaticOrder S; S.init(M, D, F.G, (int)blockIdx.x);
        pg8::EpiBf16<0> E{F.FF, D, nullptr, 0, 0, 1.f};
        pg8::gemm_phase<pg8::EpiBf16<0>, pg8::StaticOrder, true, true>(F.lds + RING_OFF, g, S, E);
    } SEAM(8);
    if (IN(9)) REPS(9) { p9_rows(F); }
#undef IN
#undef SEAM
}

extern "C" void kernel_launch(void* const* d_in, const int* in_sizes, int n_in, void* d_out, int out_size, void* d_ws, size_t ws_size, hipStream_t stream) {
    static int grid = 0;
    if (grid == 0) {
        if (n_in != 24 || in_sizes[0] != MP * D || in_sizes[1] != MS * D || out_size != M * D + NB * 2 * LW || ws_size < WS_END) {
            fprintf(stderr, "kernel_launch: unexpected shapes: n_in %d, in0 %d, in1 %d, out %d, ws %zu; nothing launched\n", n_in, n_in > 0 ? in_sizes[0] : -1, n_in > 1 ? in_sizes[1] : -1, out_size, ws_size); grid = -1; return; }
        int dev = 0, cus = 0, per_cu = 0;
        if (hipGetDevice(&dev) != hipSuccess || hipDeviceGetAttribute(&cus, hipDeviceAttributeMultiprocessorCount, dev) != hipSuccess) { fprintf(stderr, "kernel_launch: device query failed\n"); grid = -1; return; }
        if (hipFuncSetAttribute((const void*)mega_fwd, hipFuncAttributeMaxDynamicSharedMemorySize, LDS_BYTES) != hipSuccess) { fprintf(stderr, "kernel_launch: hipFuncSetAttribute failed\n"); grid = -1; return; }
        if (hipOccupancyMaxActiveBlocksPerMultiprocessor(&per_cu, (const void*)mega_fwd, NWAVES * 64, LDS_BYTES) != hipSuccess || per_cu < 1) {
            fprintf(stderr, "kernel_launch: occupancy query reports %d workgroups per CU: the grid cannot be resident; nothing launched\n", per_cu); (void)hipGetLastError(); grid = -1; return; }
        grid = cus;
    }
    if (grid < 0) return;
    if (hipMemsetAsync((char*)d_ws + WS_CTL, 0, CTL_ZERO_BYTES, stream) != hipSuccess) { fprintf(stderr, "kernel_launch: hipMemsetAsync failed\n"); return; }
    Args a{};
    for (int i = 0; i < 24; ++i) a.in[i] = (const float*)d_in[i];
    a.out = (float*)d_out; a.ws = (unsigned char*)d_ws;
#if MK_ONE_LAUNCH
    a.ph_lo = 0; a.ph_hi = N_PHASES;
    hipLaunchKernelGGL(mega_fwd, dim3(grid), dim3(NWAVES * 64), LDS_BYTES, stream, a);
#else
    for (int p = 0; p < N_PHASES; ++p) { a.ph_lo = p; a.ph_hi = p + 1; hipLaunchKernelGGL(mega_fwd, dim3(grid), dim3(NWAVES * 64), LDS_BYTES, stream, a); }
#endif
    const hipError_t le = hipPeekAtLastError();
    if (le != hipSuccess) fprintf(stderr, "kernel_launch: launch failed: %s (grid %d x %d threads, %d B LDS)\n", hipGetErrorName(le), grid, NWAVES * 64, LDS_BYTES);
}
```

```cpp
#include <hip/hip_runtime.h>
#include <cstdio>
#include <cstdint>
namespace pg8 {
#define PG8_LAS __attribute__((address_space(3)))
typedef unsigned short bf16_t;
typedef short bf16x8 __attribute__((ext_vector_type(8)));
typedef float f32x4 __attribute__((ext_vector_type(4)));
typedef unsigned u32x4 __attribute__((ext_vector_type(4)));
constexpr int BM = 256, BK = 64, HALF = 128, HTB = HALF * BK * 2  , STAGE_BYTES = 8 * HTB, NXCD = 8, WGM = 8;

__host__ __device__ __forceinline__ int lds_byte(int r, int c) { const int st = (r >> 4) * 2 + (c >> 5), rr = r & 15, cc = c & 31, ob = rr * 64 + cc * 2; return st * 1024 + (ob ^ (((ob >> 9) & 1) << 5)); }
__host__ __device__ __forceinline__ void stage_rc(int b, int& R, int& C) { const int st = b / 1024, sb = b % 1024, swz = sb ^ (((sb >> 9) & 1) << 5); R = (st >> 1) * 16 + swz / 64; C = (st & 1) * 32 + (swz % 64) / 2; }
__host__ __device__ __forceinline__ int perm32(int rho) { const int n = rho >> 4, i = rho & 15; return 8 * (i >> 2) + 4 * n + (i & 3); }

struct Unit { int pm, pn; };
struct Gemm { const bf16_t* A; const bf16_t* Bt; int M, N, K; };

struct StaticOrder {
    int nM, nN, nwg, G, c;
    __host__ __device__ void init(int M, int N, int G_, int c_) { nM = M / BM; nN = N / BM; nwg = nM * nN; G = G_; c = c_; }
    __host__ __device__ bool next(int i, Unit& u) const {
        const long L = (long)i * G + c; if (L >= nwg) return false;
        int wgid = (int)L; { const int q = nwg / NXCD, r = nwg % NXCD, xcd = wgid % NXCD, off = wgid / NXCD; wgid = (xcd < r ? xcd * (q + 1) : r * (q + 1) + (xcd - r) * q) + off; }
        const int nig = WGM * nN, gid = wgid / nig, fm = gid * WGM, gsz = (nM - fm) < WGM ? (nM - fm) : WGM;
        u.pm = fm + ((wgid % nig) % gsz); u.pn = (wgid % nig) / gsz; return true;
    }
    __device__ __forceinline__ void a_ready(const Unit&) const {}
    __device__ __forceinline__ void done(const Unit&) const {}
};

__device__ __forceinline__ unsigned cvt_pk_bf16(float lo, float hi) { unsigned r; asm volatile("v_cvt_pk_bf16_f32 %0, %1, %2" : "=v"(r) : "v"(lo), "v"(hi)); return r; }
typedef float f32x2 __attribute__((ext_vector_type(2)));
__device__ __forceinline__ f32x2 gelu_pk(f32x2 v) {
    const f32x2 av = __builtin_elementwise_abs(v), d = av * 0.2316418882f + 1.0f;
    f32x2 t; t.x = __builtin_amdgcn_rcpf(d.x); t.y = __builtin_amdgcn_rcpf(d.y);
    f32x2 q = t * 0.5307027145f + (-0.7265760135f); q = q * t + 0.7107068705f; q = q * t + (-0.142248368f); q = q * t + 0.127414796f; q = q * t;
    const f32x2 s = (v * v) * (-0.72134752044f);
    f32x2 e; e.x = __builtin_amdgcn_exp2f(s.x); e.y = __builtin_amdgcn_exp2f(s.y);
    const f32x2 m = v * (q * e), r = v - m;
    f32x2 o; o.x = v.x < 0.f ? m.x : r.x; o.y = v.y < 0.f ? m.y : r.y; return o;
}

template <int ACT  > struct EpiBf16 {
    static constexpr bool PERM = true, AFTER_DRAIN = false; static_assert(ACT == 0 || ACT == 1, "EpiBf16: ACT is 0 (none) or 1 (gelu_pk)");
    bf16_t* O; int ldc; const float* bias; int split_cols; size_t split_stride; float scale0;
    __device__ __forceinline__ void operator()(const f32x4 (&acc)[2][2][4][2], const Unit& u, int wr, int wc, int fr, int fq) const {
        const int row0 = u.pm * BM + wr * 64 + fr; int colt = u.pn * BM; bf16_t* base = O;
        float sc = 1.f; if (split_cols) { const int t = colt / split_cols; base += (size_t)t * split_stride; colt -= t * split_cols; if (t == 0) sc = scale0; }
        const int col0 = colt + wc * 32 + 8 * fq, bcol0 = u.pn * BM + wc * 32 + 8 * fq;
        f32x4 bv[2][2];
#pragma unroll
        for (int bj = 0; bj < 2; ++bj)
#pragma unroll
            for (int n = 0; n < 2; ++n) bv[bj][n] = bias ? *(const f32x4*)(bias + bcol0 + bj * HALF + 4 * n) : (f32x4){0.f, 0.f, 0.f, 0.f};
#pragma unroll
        for (int ai = 0; ai < 2; ++ai)
#pragma unroll
            for (int m = 0; m < 4; ++m) { bf16_t* rowp = base + (size_t)(row0 + ai * HALF + m * 16) * ldc + col0;
#pragma unroll
                for (int bj = 0; bj < 2; ++bj) { f32x4 v0 = acc[ai][bj][m][0] + bv[bj][0], v1 = acc[ai][bj][m][1] + bv[bj][1];
                    if (ACT == 1) { f32x2 a = gelu_pk((f32x2){v0[0], v0[1]}), b = gelu_pk((f32x2){v0[2], v0[3]}), c = gelu_pk((f32x2){v1[0], v1[1]}), d = gelu_pk((f32x2){v1[2], v1[3]});
                        v0 = (f32x4){a.x, a.y, b.x, b.y}; v1 = (f32x4){c.x, c.y, d.x, d.y}; }
                    v0 = v0 * sc; v1 = v1 * sc; u32x4 w; w.x = cvt_pk_bf16(v0[0], v0[1]); w.y = cvt_pk_bf16(v0[2], v0[3]); w.z = cvt_pk_bf16(v1[0], v1[1]); w.w = cvt_pk_bf16(v1[2], v1[3]);
                    *(u32x4*)(rowp + bj * HALF) = w; } }
    }
};
struct EpiF32 {
    static constexpr bool PERM = false, AFTER_DRAIN = false;
    float* C; int ldc;
    __device__ __forceinline__ void operator()(const f32x4 (&acc)[2][2][4][2], const Unit& u, int wr, int wc, int fr, int fq) const {
        const int row0 = u.pm * BM + wr * 64 + fr, col0 = u.pn * BM + wc * 32 + 4 * fq;
#pragma unroll
        for (int ai = 0; ai < 2; ++ai)
#pragma unroll
            for (int m = 0; m < 4; ++m) { float* rowp = C + (size_t)(row0 + ai * HALF + m * 16) * ldc + col0;
#pragma unroll
                for (int bj = 0; bj < 2; ++bj)
#pragma unroll
                    for (int n = 0; n < 2; ++n) *(f32x4*)(rowp + bj * HALF + n * 16) = acc[ai][bj][m][n]; }
    }
};
struct EpiSwiglu {
    static constexpr bool PERM = true, AFTER_DRAIN = false;
    bf16_t* O; int ldc;
    __device__ __forceinline__ void operator()(const f32x4 (&acc)[2][2][4][2], const Unit& u, int wr, int wc, int fr, int fq) const {
        const int row0 = u.pm * BM + wr * 64 + fr, col0 = u.pn * HALF + wc * 32 + 8 * fq;
#pragma unroll
        for (int ai = 0; ai < 2; ++ai)
#pragma unroll
            for (int m = 0; m < 4; ++m) { bf16_t* rowp = O + (size_t)(row0 + ai * HALF + m * 16) * ldc + col0;
                float o[8];
#pragma unroll
                for (int n = 0; n < 2; ++n)
#pragma unroll
                    for (int e = 0; e < 4; ++e) { const float g = acc[ai][0][m][n][e], up = acc[ai][1][m][n][e];
                        o[4 * n + e] = g * __builtin_amdgcn_rcpf(1.0f + __builtin_amdgcn_exp2f(-1.4426950408889634f * g)) * up; }
                u32x4 w; w.x = cvt_pk_bf16(o[0], o[1]); w.y = cvt_pk_bf16(o[2], o[3]); w.z = cvt_pk_bf16(o[4], o[5]); w.w = cvt_pk_bf16(o[6], o[7]);
                *(u32x4*)rowp = w; }
    }
};

template <class Epi, class Sched, bool ALIGN_EPI = false, bool SP2 = false>
__device__ __forceinline__ void gemm_phase(PG8_LAS unsigned char* lds, const Gemm g, const Sched& S, const Epi& E) {
    const int tid = threadIdx.x, wid = __builtin_amdgcn_readfirstlane(tid >> 6), lane = tid & 63, wr = wid >> 2, wc = wid & 3, fr = lane & 15, fq = lane >> 4;
    const int K = g.K, nt = K / BK;
    unsigned voffA[2], voffB[2];
#pragma unroll
    for (int i = 0; i < 2; ++i) { int R, C; stage_rc(tid * 16 + i * 8192, R, C); const int Rb = Epi::PERM ? ((R & ~31) + perm32(R & 31)) : R;
        voffA[i] = (unsigned)(R * K + C) * 2u; voffB[i] = (unsigned)(Rb * K + C) * 2u; }
    const size_t kstep = (size_t)(BK * 2);
    const size_t hstep = (size_t)HALF * K * 2;
    const size_t tstep = 2 * hstep;
    const unsigned ldsw = (unsigned)wid * 1024u;
    const int aoff = lds_byte(wr * 64 + fr, fq * 8), boff = lds_byte(wc * 32 + fr, fq * 8);
#define PG8_SA(b, h) (((b) * 2 + (h)) * HTB)
#define PG8_SB(b, h) ((4 + (b) * 2 + (h)) * HTB)
#define PG8_STAGE(bufoff, gbase, voff) do { _Pragma("unroll") for (int _i = 0; _i < 2; ++_i) \
        __builtin_amdgcn_global_load_lds((const unsigned*)((const char*)(gbase) + (voff)[_i]), (PG8_LAS unsigned*)(lds + (bufoff) + ldsw + _i * 8192), 16, 0, 0); } while (0)
#define PG8_LDA(dst, b, h) do { _Pragma("unroll") for (int m = 0; m < 4; ++m) _Pragma("unroll") for (int k = 0; k < 2; ++k) dst[m][k] = *(const PG8_LAS bf16x8*)(lds + PG8_SA(b, h) + aoff + m * 2048 + k * 1024); } while (0)
#define PG8_LDB(dst, b, h) do { _Pragma("unroll") for (int n = 0; n < 2; ++n) _Pragma("unroll") for (int k = 0; k < 2; ++k) dst[n][k] = *(const PG8_LAS bf16x8*)(lds + PG8_SB(b, h) + boff + n * 2048 + k * 1024); } while (0)
#define PG8_MMA(ai, bj, At, Bt) do { __builtin_amdgcn_s_setprio(1); _Pragma("unroll") for (int m = 0; m < 4; ++m) _Pragma("unroll") for (int n = 0; n < 2; ++n) _Pragma("unroll") for (int k = 0; k < 2; ++k) \
        acc[ai][bj][m][n] = __builtin_amdgcn_mfma_f32_16x16x32_bf16(Bt[n][k], At[m][k], acc[ai][bj][m][n], 0, 0, 0); __builtin_amdgcn_s_setprio(0); } while (0)
#define PG8_WAIT_V(n) asm volatile("s_waitcnt vmcnt(" #n ")" ::: "memory")
#define PG8_WAIT_L(n) asm volatile("s_waitcnt lgkmcnt(" #n ")" ::: "memory")
#define PG8_BAR __builtin_amdgcn_s_barrier()
#define PG8_SCHED __builtin_amdgcn_sched_barrier(0)
    Unit cur, nxt; int ui = 0;
    if (!S.next(0, cur)) return;
    f32x4 acc[2][2][4][2];
#pragma unroll
    for (int a = 0; a < 2; ++a)
#pragma unroll
        for (int b = 0; b < 2; ++b)
#pragma unroll
            for (int m = 0; m < 4; ++m)
#pragma unroll
                for (int n = 0; n < 2; ++n) acc[a][b][m][n] = (f32x4){0.f, 0.f, 0.f, 0.f};
    bf16x8 At[4][2], B0[2][2], B1[2][2];
    const char* cA = (const char*)g.A + (size_t)cur.pm * tstep; const char* cB = (const char*)g.Bt + (size_t)cur.pn * tstep;
    S.a_ready(cur);
    if constexpr (SP2) {
        PG8_STAGE(PG8_SB(0, 0), cB, voffB); PG8_STAGE(PG8_SB(0, 1), cB + hstep, voffB); PG8_STAGE(PG8_SA(0, 0), cA, voffA); PG8_STAGE(PG8_SA(0, 1), cA + hstep, voffA);
        if (wr == 1) PG8_BAR;
        PG8_WAIT_V(2); PG8_BAR;
        PG8_STAGE(PG8_SB(1, 0), cB + kstep, voffB); PG8_STAGE(PG8_SA(1, 0), cA + kstep, voffA); PG8_STAGE(PG8_SB(1, 1), cB + hstep + kstep, voffB);
        PG8_WAIT_V(6); PG8_BAR;
    } else {
        PG8_STAGE(PG8_SB(0, 0), cB, voffB); PG8_STAGE(PG8_SA(0, 0), cA, voffA); PG8_STAGE(PG8_SB(0, 1), cB + hstep, voffB); PG8_STAGE(PG8_SA(0, 1), cA + hstep, voffA);
        if (wr == 1) PG8_BAR;
        PG8_WAIT_V(4); PG8_BAR;
        PG8_STAGE(PG8_SB(1, 0), cB + kstep, voffB); PG8_STAGE(PG8_SA(1, 0), cA + kstep, voffA); PG8_STAGE(PG8_SB(1, 1), cB + hstep + kstep, voffB);
        PG8_WAIT_V(6); PG8_BAR;
    }
    for (;;) {
        const bool has_next = S.next(ui + 1, nxt);
        const char* nA = has_next ? (const char*)g.A + (size_t)nxt.pm * tstep : cA; const char* nB = has_next ? (const char*)g.Bt + (size_t)nxt.pn * tstep : cB;
        for (int t = 0; t < nt; t += 2) {
            const bool last = (t == nt - 2);
            const char* a1 = cA + (size_t)(t + 1) * kstep;
            const char* a2 = last ? nA : cA + (size_t)(t + 2) * kstep; const char* b2 = last ? nB : cB + (size_t)(t + 2) * kstep;
            const char* a3 = a2 + kstep; const char* b3 = b2 + kstep;
            if (last && has_next) S.a_ready(nxt);
            if constexpr (SP2) {
            PG8_LDB(B0, 0, 0); PG8_LDB(B1, 0, 1); PG8_SCHED; PG8_LDA(At, 0, 0); PG8_STAGE(PG8_SA(1, 1), a1 + hstep, voffA);
            PG8_WAIT_V(8); PG8_WAIT_L(0); PG8_BAR; PG8_MMA(0, 0, At, B0); PG8_MMA(0, 1, At, B1); PG8_BAR; PG8_SCHED;
            PG8_LDA(At, 0, 1); PG8_STAGE(PG8_SB(0, 0), b2, voffB); PG8_STAGE(PG8_SB(0, 1), b2 + hstep, voffB); PG8_STAGE(PG8_SA(0, 0), a2, voffA);
            PG8_WAIT_V(8); PG8_WAIT_L(0); PG8_BAR; PG8_MMA(1, 0, At, B0); PG8_MMA(1, 1, At, B1); PG8_BAR; PG8_SCHED;
            PG8_LDB(B0, 1, 0); PG8_LDB(B1, 1, 1); PG8_SCHED; PG8_LDA(At, 1, 0); PG8_STAGE(PG8_SA(0, 1), a2 + hstep, voffA);
            PG8_WAIT_V(8); PG8_WAIT_L(0); PG8_BAR; PG8_MMA(0, 0, At, B0); PG8_MMA(0, 1, At, B1); PG8_BAR; PG8_SCHED;
            PG8_LDA(At, 1, 1); PG8_STAGE(PG8_SB(1, 0), b3, voffB); PG8_STAGE(PG8_SB(1, 1), b3 + hstep, voffB); PG8_STAGE(PG8_SA(1, 0), a3, voffA);
            PG8_WAIT_V(8); PG8_WAIT_L(0); PG8_BAR; PG8_MMA(1, 0, At, B0); PG8_MMA(1, 1, At, B1); PG8_BAR; PG8_SCHED;
            } else {
            PG8_LDB(B0, 0, 0); PG8_SCHED; PG8_LDA(At, 0, 0); PG8_STAGE(PG8_SA(1, 1), a1 + hstep, voffA);
            PG8_WAIT_L(8); PG8_BAR; PG8_WAIT_L(0); PG8_MMA(0, 0, At, B0); PG8_BAR; PG8_SCHED;
            PG8_LDB(B1, 0, 1); PG8_STAGE(PG8_SB(0, 0), b2, voffB);
            PG8_BAR; PG8_WAIT_L(0); PG8_MMA(0, 1, At, B1); PG8_BAR;
            PG8_LDA(At, 0, 1); PG8_STAGE(PG8_SA(0, 0), a2, voffA);
            PG8_BAR; PG8_WAIT_L(0); PG8_MMA(1, 0, At, B0); PG8_BAR; PG8_SCHED;
            PG8_STAGE(PG8_SB(0, 1), b2 + hstep, voffB);
            PG8_WAIT_V(6); PG8_BAR; PG8_MMA(1, 1, At, B1); PG8_BAR;
            PG8_LDB(B0, 1, 0); PG8_SCHED; PG8_LDA(At, 1, 0); PG8_STAGE(PG8_SA(0, 1), a2 + hstep, voffA);
            PG8_WAIT_L(8); PG8_BAR; PG8_WAIT_L(0); PG8_MMA(0, 0, At, B0); PG8_BAR; PG8_SCHED;
            PG8_LDB(B1, 1, 1); PG8_STAGE(PG8_SB(1, 0), b3, voffB);
            PG8_BAR; PG8_WAIT_L(0); PG8_MMA(0, 1, At, B1); PG8_BAR;
            PG8_LDA(At, 1, 1); PG8_STAGE(PG8_SA(1, 0), a3, voffA);
            PG8_BAR; PG8_WAIT_L(0); PG8_MMA(1, 0, At, B0); PG8_BAR; PG8_SCHED;
            PG8_STAGE(PG8_SB(1, 1), b3 + hstep, voffB);
            PG8_WAIT_V(6); PG8_BAR; PG8_MMA(1, 1, At, B1); PG8_BAR;
            }
        }
        if constexpr (ALIGN_EPI) { if (wr == 0) PG8_BAR; }
        if constexpr (!Epi::AFTER_DRAIN) { E(acc, cur, wr, wc, fr, fq); S.done(cur); }
        if (!has_next) break;
#pragma unroll
        for (int a = 0; a < 2; ++a)
#pragma unroll
            for (int b = 0; b < 2; ++b)
#pragma unroll
                for (int m = 0; m < 4; ++m)
#pragma unroll
                    for (int n = 0; n < 2; ++n) acc[a][b][m][n] = (f32x4){0.f, 0.f, 0.f, 0.f};
        cur = nxt; cA = nA; cB = nB; ++ui;
        if constexpr (ALIGN_EPI) { if (wr == 1) PG8_BAR; }
    }
    PG8_WAIT_V(0);
    if constexpr (!ALIGN_EPI) { if (wr == 0) PG8_BAR; }
    PG8_BAR;
    if constexpr (Epi::AFTER_DRAIN) { E.fused(acc, cur, wr, wc, fr, fq, lds, wid, lane); S.done(cur); }
#undef PG8_SA
#undef PG8_SB
#undef PG8_STAGE
#undef PG8_LDA
#undef PG8_LDB
#undef PG8_MMA
#undef PG8_WAIT_V
#undef PG8_WAIT_L
#undef PG8_BAR
#undef PG8_SCHED
}
}

constexpr int NWAVES = 8;
#ifndef MK_ONE_LAUNCH
#define MK_ONE_LAUNCH 1
#endif
constexpr int N_PHASES = 10;

constexpr int D = 1024, NB = 32, SEQ = 256, DB = 4, DSEQ = 4096, GRIDW = 64;
constexpr int MP = NB * SEQ, MS = DB * DSEQ, M = MP + MS;
constexpr int NIN = 1536, PW = 512, LW = 512, DFF = 2816, NMOD = 6 * D, NHEAD = 8, HD = 64;
constexpr int NCH = M / 256, NCH_P = MP / 256, NCH_S = MS / 256;
constexpr float EPS = 1e-6f;

constexpr size_t MiB = 1u << 20, KiB = 1u << 10;
constexpr size_t WS_CTL = 0, CTL_ZERO_BYTES = 1 * MiB;
constexpr size_t WS_MOD = 64 * KiB;
constexpr size_t WS_WIN = 1 * MiB, WS_WOUT = 4 * MiB, WS_WFI = 6 * MiB, WS_WFO = 17 * MiB;
constexpr size_t WS_WCAT = 23 * MiB, WS_WPT = WS_WCAT + 256 * KiB, WS_LSC = WS_WPT + 128 * KiB, WS_CAGG = WS_WCAT + 512 * KiB;
constexpr size_t WS_XN = 24 * MiB;
constexpr size_t WS_U = 72 * MiB;
constexpr size_t WS_FF = 72 * MiB;
constexpr size_t WS_ACT = 124 * MiB;
constexpr size_t WS_END = 256 * MiB;
static_assert(WS_WFO + (size_t)D * DFF * 2 <= WS_WCAT && WS_CAGG + (size_t)NCH_S * 2 * LW * 8 <= WS_XN && WS_ACT + (size_t)M * DFF * 2 <= WS_END && WS_MOD + 5 * NMOD * 4 <= CTL_ZERO_BYTES, "d_ws map");
constexpr int CW_BAR = 4096;

constexpr int LDS_BYTES = 147456;
constexpr int MISC_OFF = LDS_BYTES - 256;
constexpr int RING_OFF = 0;

#define GAS __attribute__((address_space(1)))
#define LAS __attribute__((address_space(3)))
typedef unsigned short bf16;
typedef unsigned v4u __attribute__((ext_vector_type(4)));
typedef unsigned v2u __attribute__((ext_vector_type(2)));
typedef float f32x4 __attribute__((ext_vector_type(4)));
typedef float f32x2 __attribute__((ext_vector_type(2)));
typedef short bf16x8 __attribute__((ext_vector_type(8)));
typedef GAS unsigned gu32;
typedef GAS unsigned long long gu64;
#define RLX_AGENT __ATOMIC_RELAXED, __HIP_MEMORY_SCOPE_AGENT
#define LDS_WAIT() asm volatile("s_waitcnt lgkmcnt(0)" ::: "memory")
#define VM_WAIT() asm volatile("s_waitcnt vmcnt(0)" ::: "memory")
__device__ __forceinline__ unsigned f2bf(float f) { unsigned u = __builtin_bit_cast(unsigned, f); return (u + 0x7fffu + ((u >> 16) & 1u)) >> 16; }
__device__ __forceinline__ unsigned pk2(float lo, float hi) { return f2bf(lo) | (f2bf(hi) << 16); }
__device__ __forceinline__ float bflo(unsigned w) { return __builtin_bit_cast(float, w << 16); }
__device__ __forceinline__ float bfhi(unsigned w) { return __builtin_bit_cast(float, w & 0xffff0000u); }
__device__ __forceinline__ float fsigmoid(float z) { return __builtin_amdgcn_rcpf(1.0f + __builtin_amdgcn_exp2f(-1.4426950408889634f * z)); }

#define XB_TMO      128
#define XB_XCNT(j)  (256  + 64 * (j))
#define XB_XSUB(j)  (1280 + 64 * (j))
#define XB_XGEN(j)  (2304 + 64 * (j))
#define XB_TOP      3328
#define XB_TOPGEN   3392
#define XCD_BAR_WORDS 3456
#define XB_SPIN_CAP (1u << 18)

__device__ __forceinline__ unsigned xb_ld(unsigned* p)              { return __hip_atomic_load(p, __ATOMIC_RELAXED, __HIP_MEMORY_SCOPE_AGENT); }
__device__ __forceinline__ unsigned xb_add(unsigned* p, unsigned v) { return __hip_atomic_fetch_add(p, v, __ATOMIC_RELAXED, __HIP_MEMORY_SCOPE_AGENT); }
__device__ __forceinline__ unsigned xb_xcc_id() { return (unsigned)__builtin_amdgcn_s_getreg((3 << 11) | 20) & 0xFu; }
#define XB_SPIN(cond, bar) do { unsigned _sp = 0; while (cond) { __builtin_amdgcn_s_sleep(1); \
    if ((++_sp & 255u) == 0u) { if (xb_ld(&(bar)[XB_TMO])) break; if (_sp > XB_SPIN_CAP) { atomicAdd(&(bar)[XB_TMO], 1u); break; } } } } while (0)

struct XcdBarrier {
    unsigned* bar; unsigned x;
    volatile LAS unsigned* st;
};

__device__ __forceinline__ XcdBarrier xcd_barrier_post(unsigned* bar, volatile LAS unsigned* st) {
    XcdBarrier b; b.bar = bar; b.x = xb_xcc_id(); b.st = st;
    if (threadIdx.x == 0) (void)xb_add(&bar[XB_XCNT(b.x)], 1u);
    return b;
}
__device__ __forceinline__ void xcd_barrier_complete(unsigned* bar, unsigned x, unsigned& nloc, unsigned& nx) {
    const unsigned G = gridDim.x * gridDim.y * gridDim.z;
    unsigned sum, cnt, mine, sp = 0u;
    for (;;) {
        sum = 0u; cnt = 0u; mine = 0u;
#pragma unroll
        for (unsigned j = 0; j < 16; ++j) { const unsigned c = xb_ld(&bar[XB_XCNT(j)]); sum += c; cnt += (c > 0u) ? 1u : 0u; mine = (j == x) ? c : mine; }
        if (sum == G) break;
        __builtin_amdgcn_s_sleep(1);
        if ((++sp & 255u) == 0u) { if (xb_ld(&bar[XB_TMO])) break; if (sp > XB_SPIN_CAP) { atomicAdd(&bar[XB_TMO], 1u); break; } }
    }
    nloc = mine > 0u ? mine : 1u; nx = cnt > 0u ? cnt : 1u;
}

__device__ __forceinline__ void xcd_barrier(const XcdBarrier& b) {
    asm volatile("s_waitcnt vmcnt(0)" ::: "memory");
    __syncthreads();
    if (threadIdx.x == 0) {
        unsigned* bar = b.bar;
        __builtin_amdgcn_s_waitcnt(0);
        unsigned nloc = b.st[0], nx = b.st[1];
        if (nloc == 0u) { xcd_barrier_complete(bar, b.x, nloc, nx); b.st[0] = nloc; b.st[1] = nx; }
        const unsigned old = xb_add(&bar[XB_XSUB(b.x)], 1u);
        const unsigned gen = old / nloc;
        if (old + 1u == (gen + 1u) * nloc) {
            __builtin_amdgcn_fence(__ATOMIC_RELEASE, "agent");
            asm volatile("s_waitcnt vmcnt(0)" ::: "memory");
            const unsigned og = xb_add(&bar[XB_TOP], 1u);
            const unsigned tg = og / nx;
            if (og + 1u == (tg + 1u) * nx) xb_add(&bar[XB_TOPGEN], 1u);
            else XB_SPIN(xb_ld(&bar[XB_TOPGEN]) == tg, bar);
            __builtin_amdgcn_fence(__ATOMIC_ACQUIRE, "agent");
            xb_add(&bar[XB_XGEN(b.x)], 1u);
            asm volatile("s_waitcnt vmcnt(0)" ::: "memory");
        } else {
            XB_SPIN(xb_ld(&bar[XB_XGEN(b.x)]) == gen, bar);
            __builtin_amdgcn_fence(__ATOMIC_ACQUIRE, "agent");
            asm volatile("s_waitcnt vmcnt(0)" ::: "memory");
        }
    }
    __syncthreads();
}

struct Frame {
    LAS unsigned char* lds;
    volatile LAS unsigned* MISC;
    gu32* ctl;
    int tid, lane, wave;
    int vcu, G;
    const float *xp, *xs, *c, *state, *cctx, *wmod, *bmod, *g_mix_pre, *g_mix_post, *g_ffn_pre, *g_ffn_post, *w_in, *w_pool, *pscale, *convw, *convb, *wa, *ba, *wx, *bx, *lam, *w_out, *w_fi, *w_fo;
    float* out; float* newstate;
    float* MOD;
    bf16 *Win_t, *Wout_t, *Wfi_t, *Wfo_t, *Wcat, *Wpt;
    float* LSC;
    f32x2* CAGG;
    bf16 *XN, *U, *MIX, *H2, *ACT;
    bf16 *MIXO, *FF;
};
__device__ __forceinline__ const float* xrow(const Frame& F, int row) { return row < MP ? F.xp + (size_t)row * D : F.xs + (size_t)(row - MP) * D; }
__device__ __forceinline__ int mod_idx(int row) { return row < MP ? 0 : 1 + (row - MP) / DSEQ; }
__device__ __forceinline__ float wave_sum(float v) {
#pragma unroll
    for (int o = 1; o < 64; o <<= 1) v += __shfl_xor(v, o);
    return v;
}

__device__ __forceinline__ void p0_transpose_item(const float* W, int K, int N, bf16* WT, int k0, int n0, int drow0, LAS float* scr, int lane) {
#pragma unroll 8
    for (int i = 0; i < 32; ++i) { const int kk = 2 * i + (lane >> 5); scr[kk * 33 + (lane & 31)] = W[(size_t)(k0 + kk) * N + n0 + (lane & 31)]; }
    LDS_WAIT(); asm volatile("" ::: "memory");
    const int c = lane & 7;
#pragma unroll
    for (int j = 0; j < 4; ++j) { const int n = (lane >> 3) + 8 * j; const LAS float* s = scr + (8 * c) * 33 + n;
        v4u o; o.x = pk2(s[0 * 33], s[1 * 33]); o.y = pk2(s[2 * 33], s[3 * 33]); o.z = pk2(s[4 * 33], s[5 * 33]); o.w = pk2(s[6 * 33], s[7 * 33]);
        *(GAS v4u*)(WT + (size_t)(drow0 + n) * K + k0 + 8 * c) = o; }
    LDS_WAIT(); asm volatile("" ::: "memory");
}
__device__ __forceinline__ void p0_prologue(Frame& F) {
    LAS float* scr = (LAS float*)(F.lds + RING_OFF + F.wave * 16384);
    const int gw = F.vcu * NWAVES + F.wave, NGW = F.G * NWAVES, lane = F.lane;
    constexpr int MOD_UNITS = (NMOD / 64) * (D / 64);
    for (int it = gw; it < MOD_UNITS; it += NGW) {
        const int cg = it % (NMOD / 64), ks = it / (NMOD / 64), col = cg * 64 + lane, k0 = ks * 64;
        float sv[5];
#pragma unroll
        for (int v = 0; v < 5; ++v) { const float x = v == 0 ? F.cctx[k0 + lane] : F.c[(v - 1) * D + k0 + lane]; sv[v] = x * fsigmoid(x); }
        float acc[5] = {0.f, 0.f, 0.f, 0.f, 0.f};
#pragma unroll 16
        for (int kk = 0; kk < 64; ++kk) { const float w = F.wmod[(size_t)(k0 + kk) * NMOD + col];
#pragma unroll
            for (int v = 0; v < 5; ++v) acc[v] += __shfl(sv[v], kk) * w; }
        const float bm = ks == 0 ? F.bmod[col] : 0.f;
#pragma unroll
        for (int v = 0; v < 5; ++v) atomicAdd(F.MOD + v * NMOD + col, acc[v] + bm);
    }
    constexpr int I_IN = (D / 64) * (NIN / 32), I_OUT = (D / 64) * (D / 32), I_FI = (D / 64) * (2 * DFF / 32), I_FO = (DFF / 64) * (D / 32);
    constexpr int NITEMS = I_IN + I_OUT + I_FI + I_FO;
    for (int it = gw; it < NITEMS; it += NGW) {
        int r = it;
        if (r < I_IN) { const int nblk = NIN / 32, kb = r / nblk, nb = r % nblk; p0_transpose_item(F.w_in, D, NIN, F.Win_t, 64 * kb, 32 * nb, 32 * nb, scr, lane); continue; } r -= I_IN;
        if (r < I_OUT) { const int nblk = D / 32, kb = r / nblk, nb = r % nblk; p0_transpose_item(F.w_out, D, D, F.Wout_t, 64 * kb, 32 * nb, 32 * nb, scr, lane); continue; } r -= I_OUT;
        if (r < I_FI) { const int nblk = 2 * DFF / 32, kb = r / nblk, nb = r % nblk, n0 = 32 * nb;
            const int up = n0 >= DFF ? 1 : 0, j0 = n0 - up * DFF, drow0 = 256 * (j0 / 128) + 128 * up + (j0 % 128);
            p0_transpose_item(F.w_fi, D, 2 * DFF, F.Wfi_t, 64 * kb, n0, drow0, scr, lane); continue; } r -= I_FI;
        { const int nblk = D / 32, kb = r / nblk, nb = r % nblk; p0_transpose_item(F.w_fo, DFF, D, F.Wfo_t, 64 * kb, 32 * nb, 32 * nb, scr, lane); }
    }
    const int gt = F.vcu * NWAVES * 64 + F.tid, NGT = F.G * NWAVES * 64;
    for (int e = gt; e < NHEAD * 256 * 64; e += NGT) { const int i = e & 63, col = (e >> 6) & 255, h = e >> 14, type = col >> 6, j = col & 63, d = type >> 1;
        const float* src = (type & 1) ? F.wx : F.wa; F.Wcat[e] = (bf16)f2bf(src[((size_t)(d * NHEAD + h) * 64 + i) * 64 + j]); }
    for (int e = gt; e < 4 * 128 * 128; e += NGT) { const int c = e & 127, dd = (e >> 7) & 127, g = e >> 14; F.Wpt[e] = (bf16)f2bf(F.w_pool[(size_t)(g * 128 + c) * 128 + dd]); }
    for (int e = gt; e < 2 * LW; e += NGT) F.LSC[e] = -8.0f * 1.4426950408889634f * log1pf(expf(-F.lam[e]));
}

__device__ __forceinline__ void p1_xn(Frame& F) {
    const int gw = F.vcu * NWAVES + F.wave, NGW = F.G * NWAVES, lane = F.lane;
    for (int row = gw; row < M; row += NGW) {
        const GAS f32x4* xr = (const GAS f32x4*)xrow(F, row) + lane; const float* mod = F.MOD + mod_idx(row) * NMOD;
        f32x4 v[4]; float s = 0.f;
#pragma unroll
        for (int j = 0; j < 4; ++j) { v[j] = xr[64 * j]; s += (v[j].x * v[j].x + v[j].y * v[j].y) + (v[j].z * v[j].z + v[j].w * v[j].w); }
        const float r = rsqrtf(wave_sum(s) * (1.f / D) + EPS);
        GAS v2u* o8 = (GAS v2u*)(F.XN + (size_t)row * D) + lane;
#pragma unroll
        for (int j = 0; j < 4; ++j) { const int col = 256 * j + 4 * lane;
            const f32x4 g = *(const GAS f32x4*)(F.g_mix_pre + col), sc = *(const GAS f32x4*)(mod + D + col), sh = *(const GAS f32x4*)(mod + col);
            const f32x4 y = v[j] * r * g * (1.0f + sc) + sh; v2u w; w.x = pk2(y.x, y.y); w.y = pk2(y.z, y.w); o8[64 * j] = w; }
    }
}

constexpr int UX_BYTES = 264 * 128, UXA_OFF = 0, UXB_OFF = UX_BYTES, UG_OFF = 2 * UX_BYTES, WC_OFF = UG_OFF + 256 * 64, WSTR = 144, CST_OFF = WC_OFF + 128 * WSTR, WAGG_OFF = CST_OFF + 12 * 64 * 4, HC_OFF = WAGG_OFF + 8 * 2 * 32 * 8;
static_assert(HC_OFF + 256 <= MISC_OFF, "LRU LDS map");
constexpr size_t WS_ZERO = 512 * KiB;
static_assert(WS_ZERO + 128 <= CTL_ZERO_BYTES && WS_ZERO >= WS_MOD + 5 * NMOD * 4, "zero block inside the memset region");

__device__ __forceinline__ float lane_from(float v, int addr) { return __builtin_bit_cast(float, __builtin_amdgcn_ds_bpermute(addr, __builtin_bit_cast(int, v))); }

__device__ __forceinline__ void lru_dma(Frame& F, const int ci, const int h, const int c32, const int uxoff, const bool with_ux, const bool with_ug, const int w, const int lane) {
    if (w == 0) return;
    LAS unsigned char* lds = F.lds;
    const int row0 = ci * 256; const bool samp = ci >= NCH_P; const int q = samp ? ((ci - NCH_P) & 15) : 0; const bool has_prev = samp && q > 0, has_next = samp && q < 15;
    const bf16* zero = (const bf16*)((const unsigned char*)F.ctl + WS_ZERO);
#pragma unroll
    for (int j = 0; j < 7; ++j) { const int pi = (w - 1) + 7 * j;
        if (pi < 33) { if (with_ux) { const int rr = 8 * pi + (lane >> 3), c = (lane & 7) ^ ((lane >> 3) & 7);
                const bool valid = rr < 259 && (rr >= 2 || has_prev) && (rr < 258 || has_next);
                const bf16* src = valid ? F.U + (size_t)(row0 - 2 + rr) * NIN + PW + h * HD + c * 8 : zero + c * 8;
                __builtin_amdgcn_global_load_lds((const GAS unsigned*)src, (LAS unsigned*)(lds + uxoff + pi * 1024), 16, 0, 0); } }
        else if (with_ug) { const int p = pi - 33, rr = 16 * p + (lane >> 2);
            __builtin_amdgcn_global_load_lds((const GAS unsigned*)(F.U + (size_t)(row0 + rr) * NIN + PW + LW + h * HD + c32 + (lane & 3) * 8), (LAS unsigned*)(lds + UG_OFF + p * 1024), 16, 0, 0); } }
}

__device__ __forceinline__ void lru_setup(Frame& F, const int hh) {
    const int tid = F.tid, h = hh >> 1, c32 = (hh & 1) * 32; LAS unsigned char* lds = F.lds;
#pragma unroll
    for (int it = 0; it < 2; ++it) { const int idx = tid + it * NWAVES * 64, col = idx >> 3, kc = idx & 7, srow = (col >> 5) * 64 + c32 + (col & 31);
        *(LAS v4u*)(lds + WC_OFF + col * WSTR + kc * 16) = *(const GAS v4u*)(F.Wcat + ((size_t)(h * 256 + srow) * 64 + kc * 8)); }
    if (tid < 64) { const int chh = h * HD + tid; LAS float* c = (LAS float*)(lds + CST_OFF) + tid;
        c[0] = F.convw[chh]; c[64] = F.convw[LW + chh]; c[128] = F.convw[2 * LW + chh]; c[192] = F.convw[3 * LW + chh]; c[256] = F.convb[chh];
        c[320] = F.ba[chh]; c[384] = F.ba[LW + chh]; c[448] = F.bx[chh]; c[512] = F.bx[LW + chh]; c[576] = F.LSC[chh]; c[640] = F.LSC[LW + chh]; c[704] = 0.f; }
}

template <bool FULL>
__device__ __forceinline__ void lru_unit(Frame& F, const int ci, const int hh, const int uxoff, const int nci  ) {
    int tid = F.tid, w = F.wave; asm volatile("" : "+v"(tid)); asm volatile("" : "+s"(w));
    const int lane = tid & 63, fr = lane & 15, fq = lane >> 4, h = hh >> 1, c32 = (hh & 1) * 32;
    LAS unsigned char* lds = F.lds;
    const int row0 = ci * 256; const bool samp = ci >= NCH_P; const int q = samp ? ((ci - NCH_P) & 15) : 0;
    asm volatile("s_waitcnt vmcnt(0)" ::: "memory");
    __syncthreads();
    if (w == 0) { const int d = lane >> 5, cl = lane & 31, chh = h * HD + c32 + cl; float hc = 0.f;
        if constexpr (FULL) {
            if (samp) { const int b = (ci - NCH_P) >> 4; hc = F.state[(b * 2 + d) * LW + chh]; const f32x2* cg = F.CAGG + ((size_t)(b * 16) * 2 + d) * LW + chh;
                f32x2 tq[16];
#pragma unroll
                for (int qq = 0; qq < 16; ++qq) tq[qq] = cg[(size_t)qq * 2 * LW];
                if (d == 0) {
#pragma unroll
                    for (int qq = 0; qq < 16; ++qq) if (qq < q) hc = tq[qq].x * hc + tq[qq].y; }
                else {
#pragma unroll
                    for (int qq = 15; qq >= 0; --qq) if (qq > q) hc = tq[qq].x * hc + tq[qq].y; } } }
        *(LAS float*)(lds + HC_OFF + lane * 4) = hc; }
    lru_dma(F, nci >= 0 ? nci : ci, h, c32, uxoff ^ UX_BYTES, nci >= 0, false, w, lane);
    if constexpr (FULL) lru_dma(F, ci, h, c32, 0, false, true, w, lane);
    bf16x8 afr[2][2];
#pragma unroll
    for (int ks = 0; ks < 2; ++ks) { const int c = 4 * ks + fq; float cw[5][8];
#pragma unroll
        for (int p = 0; p < 5; ++p) { const f32x4 lo = *(const LAS f32x4*)(lds + CST_OFF + (p * 64 + c * 8) * 4), hi = *(const LAS f32x4*)(lds + CST_OFF + (p * 64 + c * 8 + 4) * 4);
            cw[p][0] = lo.x; cw[p][1] = lo.y; cw[p][2] = lo.z; cw[p][3] = lo.w; cw[p][4] = hi.x; cw[p][5] = hi.y; cw[p][6] = hi.z; cw[p][7] = hi.w; }
#pragma unroll
        for (int mt = 0; mt < 2; ++mt) { const int T = 32 * w + 16 * mt + fr; float xb[8];
#pragma unroll
            for (int e = 0; e < 8; ++e) xb[e] = cw[4][e];
#pragma unroll
            for (int k = 0; k < 4; ++k) { const int r = T + k; const v4u v = *(const LAS v4u*)(lds + uxoff + r * 128 + ((c ^ (r & 7)) << 4));
                xb[0] += cw[k][0] * bflo(v.x); xb[1] += cw[k][1] * bfhi(v.x); xb[2] += cw[k][2] * bflo(v.y); xb[3] += cw[k][3] * bfhi(v.y);
                xb[4] += cw[k][4] * bflo(v.z); xb[5] += cw[k][5] * bfhi(v.z); xb[6] += cw[k][6] * bflo(v.w); xb[7] += cw[k][7] * bfhi(v.w); }
            v4u o; o.x = pk2(xb[0], xb[1]); o.y = pk2(xb[2], xb[3]); o.z = pk2(xb[4], xb[5]); o.w = pk2(xb[6], xb[7]);
            afr[mt][ks] = __builtin_bit_cast(bf16x8, o); } }
    f32x4 acc[2][8];
#pragma unroll
    for (int mt = 0; mt < 2; ++mt)
#pragma unroll
        for (int nt = 0; nt < 8; ++nt) acc[mt][nt] = (f32x4){0.f, 0.f, 0.f, 0.f};
#pragma unroll
    for (int nt = 0; nt < 8; ++nt)
#pragma unroll
        for (int ks = 0; ks < 2; ++ks) { const bf16x8 b = *(const LAS bf16x8*)(lds + WC_OFF + (16 * nt + fr) * WSTR + (32 * ks + 8 * fq) * 2);
#pragma unroll
            for (int mt = 0; mt < 2; ++mt) acc[mt][nt] = __builtin_amdgcn_mfma_f32_16x16x32_bf16(afr[mt][ks], b, acc[mt][nt], 0, 0, 0); }
#pragma unroll
    for (int cq = 0; cq < 2; ++cq) { const int ch = c32 + 16 * cq + fr, cc = ch >> 3, ce = (ch & 7) * 2; const LAS float* c = (const LAS float*)(lds + CST_OFF) + ch;
#pragma unroll
        for (int mt = 0; mt < 2; ++mt) { float ux[7], xbf[4];
#pragma unroll
            for (int r7 = 0; r7 < 7; ++r7) { const int r = 32 * w + 16 * mt + 4 * fq + r7;
                ux[r7] = __builtin_bit_cast(float, (unsigned)(*(const LAS unsigned short*)(lds + uxoff + r * 128 + ((cc ^ (r & 7)) << 4) + ce)) << 16); }
            { const float cw0 = c[0], cw1 = c[64], cw2 = c[128], cw3 = c[192], cbv = c[256];
#pragma unroll
              for (int i = 0; i < 4; ++i) xbf[i] = cbv + cw0 * ux[i] + cw1 * ux[i + 1] + cw2 * ux[i + 2] + cw3 * ux[i + 3]; }
#pragma unroll
            for (int d = 0; d < 2; ++d) { const float bA = c[320 + 64 * d], bX = c[448 + 64 * d], c8 = c[576 + 64 * d];
#pragma unroll
                for (int i = 0; i < 4; ++i) { const float r = fsigmoid(acc[mt][4 * d + cq][i] + bA), ig = fsigmoid(acc[mt][4 * d + 2 + cq][i] + bX);
                    const float a = __builtin_amdgcn_exp2f(r * c8), mult = __builtin_amdgcn_sqrtf(fmaxf(1.0f - a * a, 0.f));
                    acc[mt][4 * d + cq][i] = a; acc[mt][4 * d + 2 + cq][i] = mult * (ig * xbf[i]); } } } }
    float ea[2][2][2], eb[2][2][2];
    { const int ad1[2] = {((lane - 16) & 63) << 2, ((lane + 16) & 63) << 2}, ad2[2] = {((lane - 32) & 63) << 2, ((lane + 32) & 63) << 2}, adl[2] = {(fr + 48) << 2, fr << 2};
#pragma unroll
      for (int d = 0; d < 2; ++d) { const bool ok1 = d == 0 ? fq >= 1 : fq <= 2, ok2 = d == 0 ? fq >= 2 : fq <= 1;
#pragma unroll
        for (int cq = 0; cq < 2; ++cq) { float IA[2], IB[2], TA[2], TB[2], XA[2], XB[2];
#pragma unroll
            for (int mt = 0; mt < 2; ++mt) { const f32x4 a = acc[mt][4 * d + cq], b = acc[mt][4 * d + 2 + cq];
                float A = (a[0] * a[1]) * (a[2] * a[3]);
                float B = d == 0 ? ((b[0] * a[1] + b[1]) * a[2] + b[2]) * a[3] + b[3] : ((b[3] * a[2] + b[2]) * a[1] + b[1]) * a[0] + b[0];
                { const float pa = lane_from(A, ad1[d]), pb = lane_from(B, ad1[d]); if (ok1) { B = A * pb + B; A = A * pa; } }
                { const float pa = lane_from(A, ad2[d]), pb = lane_from(B, ad2[d]); if (ok2) { B = A * pb + B; A = A * pa; } }
                IA[mt] = A; IB[mt] = B;
                XA[mt] = lane_from(A, ad1[d]); XB[mt] = lane_from(B, ad1[d]); if (!ok1) { XA[mt] = 1.f; XB[mt] = 0.f; }
                TA[mt] = lane_from(A, adl[d]); TB[mt] = lane_from(B, adl[d]); }
            const int m1 = d == 0 ? 0 : 1, m2 = 1 - m1;
            ea[d][cq][m1] = XA[m1]; eb[d][cq][m1] = XB[m1];
            ea[d][cq][m2] = XA[m2] * TA[m1]; eb[d][cq][m2] = XA[m2] * TB[m1] + XB[m2];
            if (fq == 0) *(LAS f32x2*)(lds + WAGG_OFF + ((w * 2 + d) * 32 + 16 * cq + fr) * 8) = (f32x2){TA[m2] * TA[m1], TA[m2] * TB[m1] + TB[m2]}; } } }
    asm volatile("s_waitcnt vmcnt(0)" ::: "memory");
    __syncthreads();
    if (w == 0) { const int d = lane >> 5, cl = lane & 31, chh = h * HD + c32 + cl;
        f32x2 wg[8];
#pragma unroll
        for (int ww = 0; ww < 8; ++ww) wg[ww] = *(const LAS f32x2*)(lds + WAGG_OFF + ((ww * 2 + d) * 32 + cl) * 8);
        if constexpr (FULL) { if (!samp) { float hc = 0.f;
#pragma unroll
                for (int s = 0; s < 8; ++s) { const f32x2 t = d == 0 ? wg[s] : wg[7 - s]; hc = t.x * hc + t.y; }
                F.newstate[(ci * 2 + d) * LW + chh] = hc; } }
        else { float P = 1.f, Bc = 0.f;
#pragma unroll
            for (int s = 0; s < 8; ++s) { const f32x2 t = d == 0 ? wg[s] : wg[7 - s]; Bc = t.x * Bc + t.y; P *= t.x; }
            F.CAGG[((size_t)(ci - NCH_P) * 2 + d) * LW + chh] = (f32x2){P, Bc}; } }
    if constexpr (FULL) {
#pragma unroll
        for (int cq = 0; cq < 2; ++cq) { const int cl = 16 * cq + fr;
            float hw[2];
#pragma unroll
            for (int d = 0; d < 2; ++d) { float hc = *(const LAS float*)(lds + HC_OFF + (d * 32 + cl) * 4);
#pragma unroll
                for (int s = 0; s < 7; ++s) { const int ww = d == 0 ? s : 7 - s; const f32x2 t = *(const LAS f32x2*)(lds + WAGG_OFF + ((ww * 2 + d) * 32 + cl) * 8);
                    const bool use = d == 0 ? ww < w : ww > w; if (use) hc = t.x * hc + t.y; }
                hw[d] = hc; }
#pragma unroll
            for (int mt = 0; mt < 2; ++mt) { const f32x4 a0 = acc[mt][cq], b0 = acc[mt][2 + cq], a1 = acc[mt][4 + cq], b1 = acc[mt][6 + cq];
                float hf = ea[0][cq][mt] * hw[0] + eb[0][cq][mt], hb = ea[1][cq][mt] * hw[1] + eb[1][cq][mt];
                float y[4];
#pragma unroll
                for (int i = 0; i < 4; ++i) { hf = a0[i] * hf + b0[i]; y[i] = hf; }
#pragma unroll
                for (int i = 3; i >= 0; --i) { hb = a1[i] * hb + b1[i]; y[i] += hb; }
#pragma unroll
                for (int i = 0; i < 4; ++i) { const int t = 32 * w + 16 * mt + 4 * fq + i; LAS unsigned short* p = (LAS unsigned short*)(lds + UG_OFF + t * 64 + cl * 2);
                    const float x = __builtin_bit_cast(float, (unsigned)(*p) << 16);
                    const float ge = x * fsigmoid(1.5957691216057308f * (x + 0.044715f * x * x * x));
                    *p = (unsigned short)f2bf(y[i] * ge); } } }
        __syncthreads();
#pragma unroll
        for (int it = 0; it < 2; ++it) { const int idx = tid + it * NWAVES * 64, t = idx >> 2, c4 = idx & 3;
            *(GAS v4u*)(F.MIX + (size_t)(row0 + t) * D + PW + h * HD + c32 + c4 * 8) = *(const LAS v4u*)(lds + UG_OFF + t * 64 + c4 * 16); }
    }
}
template <bool FULL>
__device__ __forceinline__ void lru_units(Frame& F, const int ci_base, const int nunits) {
    if (F.vcu >= nunits) return;
    const int hh0 = F.vcu % 16;
    lru_setup(F, hh0);
    lru_dma(F, ci_base + F.vcu / 16, hh0 >> 1, (hh0 & 1) * 32, UXA_OFF, true, false, F.wave, F.lane);
    int buf = 0;
    for (int u = F.vcu; u < nunits; u += F.G, buf ^= 1) { const int un = u + F.G; const int hh = u % 16;
        if (hh != hh0) { __syncthreads(); lru_setup(F, hh); }
        lru_unit<FULL>(F, ci_base + u / 16, hh, buf ? UXB_OFF : UXA_OFF, (un < nunits && (un % 16) == hh) ? ci_base + un / 16 : -1); }
    asm volatile("s_waitcnt vmcnt(0)" ::: "memory");
    __syncthreads();
}

constexpr int UP_OFF = 0, UP_STRIDE = 256, PM_OFF = 36864, PM_STRIDE = 272, WP_OFF = PM_OFF + 128 * PM_STRIDE;
static_assert(PM_OFF >= 144 * UP_STRIDE && WP_OFF + 128 * PM_STRIDE <= MISC_OFF, "pool LDS map");
__device__ __forceinline__ void pool_setup(Frame& F, const int g) {
    const int tid = F.tid; LAS unsigned char* lds = F.lds;
#pragma unroll
    for (int it = 0; it < 4; ++it) { const int idx = tid + it * NWAVES * 64, dcol = idx >> 4, kc = idx & 15;
        *(LAS v4u*)(lds + WP_OFF + dcol * PM_STRIDE + kc * 16) = *(const GAS v4u*)(F.Wpt + ((size_t)(g * 128 + dcol) * 128 + kc * 8)); }
}
template <int G_>
__device__ __forceinline__ void pool_unit(Frame& F, const int blk) {
    constexpr int g = G_, WIN = 2 << g, LEFT = WIN / 2, RIGHT = WIN - 1 - LEFT;
    int tid = F.tid, w = F.wave; asm volatile("" : "+v"(tid)); asm volatile("" : "+s"(w));
    const int lane = tid & 63, fr = lane & 15, fq = lane >> 4;
    LAS unsigned char* lds = F.lds;
    const int row0 = blk * 128, segl = row0 < MP ? SEQ : GRIDW;
    __syncthreads();
    for (int idx = tid; idx < 144 * 16; idx += NWAVES * 64) { const int rr = idx >> 4, cg = idx & 15, grow = row0 - 8 + rr;
        if (grow >= 0 && grow < M) *(LAS v4u*)(lds + UP_OFF + rr * UP_STRIDE + cg * 16) = *(const GAS v4u*)(F.U + (size_t)grow * NIN + g * 128 + cg * 8); }
    __syncthreads();
#pragma unroll
    for (int it = 0; it < 4; ++it) { const int idx = tid + it * NWAVES * 64, t = idx >> 4, cg = idx & 15, row = row0 + t;
        const int tl = row < MP ? (row & (SEQ - 1)) : ((row - MP) & (GRIDW - 1)), lo = max(tl - LEFT, 0), hi = min(tl + RIGHT + 1, segl);
        float s[8] = {0.f, 0.f, 0.f, 0.f, 0.f, 0.f, 0.f, 0.f};
#pragma unroll
        for (int p = 0; p < WIN; ++p) { const int pos = tl - LEFT + p; const bool ok = pos >= 0 && pos < segl;
            v4u v = *(const LAS v4u*)(lds + UP_OFF + (t + 8 - LEFT + p) * UP_STRIDE + cg * 16); if (!ok) v = (v4u){0u, 0u, 0u, 0u};
            s[0] += bflo(v.x); s[1] += bfhi(v.x); s[2] += bflo(v.y); s[3] += bfhi(v.y); s[4] += bflo(v.z); s[5] += bfhi(v.z); s[6] += bflo(v.w); s[7] += bfhi(v.w); }
        const float inv = 1.0f / (float)(hi - lo);
        const v4u sv = *(const LAS v4u*)(lds + UP_OFF + (t + 8) * UP_STRIDE + cg * 16);
        v4u o; o.x = pk2(s[0] * inv - bflo(sv.x), s[1] * inv - bfhi(sv.x)); o.y = pk2(s[2] * inv - bflo(sv.y), s[3] * inv - bfhi(sv.y));
        o.z = pk2(s[4] * inv - bflo(sv.z), s[5] * inv - bfhi(sv.z)); o.w = pk2(s[6] * inv - bflo(sv.w), s[7] * inv - bfhi(sv.w));
        *(LAS v4u*)(lds + PM_OFF + t * PM_STRIDE + cg * 16) = o; }
    __syncthreads();
    f32x4 acc[8];
#pragma unroll
    for (int nt = 0; nt < 8; ++nt) acc[nt] = (f32x4){0.f, 0.f, 0.f, 0.f};
    { bf16x8 a[4];
#pragma unroll
      for (int ks = 0; ks < 4; ++ks) a[ks] = *(const LAS bf16x8*)(lds + PM_OFF + (16 * w + fr) * PM_STRIDE + (32 * ks + 8 * fq) * 2);
#pragma unroll
      for (int nt = 0; nt < 8; ++nt)
#pragma unroll
          for (int ks = 0; ks < 4; ++ks) acc[nt] = __builtin_amdgcn_mfma_f32_16x16x32_bf16(*(const LAS bf16x8*)(lds + WP_OFF + (16 * nt + fr) * PM_STRIDE + (32 * ks + 8 * fq) * 2), a[ks], acc[nt], 0, 0, 0); }
#pragma unroll
    for (int nt = 0; nt < 8; ++nt) { const int dcol = 16 * nt + 4 * fq; const f32x4 ps = *(const GAS f32x4*)(F.pscale + g * 128 + dcol);
        v2u o; o.x = pk2(acc[nt][0] * ps.x, acc[nt][1] * ps.y); o.y = pk2(acc[nt][2] * ps.z, acc[nt][3] * ps.w);
        *(LAS v2u*)(lds + UP_OFF + (16 * w + fr) * UP_STRIDE + dcol * 2) = o; }
    __syncthreads();
#pragma unroll
    for (int it = 0; it < 4; ++it) { const int idx = tid + it * NWAVES * 64, t = idx >> 4, cg = idx & 15;
        *(GAS v4u*)(F.MIX + (size_t)(row0 + t) * D + g * 128 + cg * 8) = *(const LAS v4u*)(lds + UP_OFF + t * UP_STRIDE + cg * 16); }
}
__device__ __forceinline__ void pool_units(Frame& F, const int ubase, const int nunits) {
    int gcur = -1;
    for (int u = F.vcu; u < ubase + nunits; u += F.G) { if (u < ubase) continue; const int v = u - ubase, g = v & 3;
        if (g != gcur) { __syncthreads(); pool_setup(F, g); gcur = g; }
        switch (g) { case 0: pool_unit<0>(F, v >> 2); break; case 1: pool_unit<1>(F, v >> 2); break; case 2: pool_unit<2>(F, v >> 2); break; default: pool_unit<3>(F, v >> 2); break; } }
    __syncthreads();
}

__device__ __forceinline__ void p6_rows(Frame& F) {
    const int gw = F.vcu * NWAVES + F.wave, NGW = F.G * NWAVES, lane = F.lane;
    for (int row = gw; row < M; row += NGW) {
        const GAS f32x4* xr = (const GAS f32x4*)xrow(F, row) + lane; const GAS v2u* mr = (const GAS v2u*)(F.MIXO + (size_t)row * D) + lane; const float* mod = F.MOD + mod_idx(row) * NMOD;
        f32x4 v[4], x[4]; float s = 0.f;
#pragma unroll
        for (int j = 0; j < 4; ++j) { const v2u mw = mr[64 * j]; v[j] = (f32x4){bflo(mw.x), bfhi(mw.x), bflo(mw.y), bfhi(mw.y)}; x[j] = xr[64 * j]; s += (v[j].x * v[j].x + v[j].y * v[j].y) + (v[j].z * v[j].z + v[j].w * v[j].w); }
        const float r = rsqrtf(wave_sum(s) * (1.f / D) + EPS); float s2 = 0.f;
#pragma unroll
        for (int j = 0; j < 4; ++j) { const int col = 256 * j + 4 * lane;
            const f32x4 gp = *(const GAS f32x4*)(F.g_mix_post + col), g1 = *(const GAS f32x4*)(mod + 2 * D + col);
            x[j] = x[j] + g1 * (v[j] * r * gp); s2 += (x[j].x * x[j].x + x[j].y * x[j].y) + (x[j].z * x[j].z + x[j].w * x[j].w); }
        const float r2 = rsqrtf(wave_sum(s2) * (1.f / D) + EPS);
        GAS f32x4* o = (GAS f32x4*)(F.out + (size_t)row * D) + lane; GAS v2u* o8 = (GAS v2u*)(F.H2 + (size_t)row * D) + lane;
#pragma unroll
        for (int j = 0; j < 4; ++j) { const int col = 256 * j + 4 * lane; o[64 * j] = x[j];
            const f32x4 g = *(const GAS f32x4*)(F.g_ffn_pre + col), sc = *(const GAS f32x4*)(mod + 4 * D + col), sh = *(const GAS f32x4*)(mod + 3 * D + col);
            const f32x4 y = x[j] * r2 * g * (1.0f + sc) + sh; v2u wv; wv.x = pk2(y.x, y.y); wv.y = pk2(y.z, y.w); o8[64 * j] = wv; }
    }
}
__device__ __forceinline__ void p9_rows(Frame& F) {
    const int gw = F.vcu * NWAVES + F.wave, NGW = F.G * NWAVES, lane = F.lane;
    for (int row = gw; row < M; row += NGW) {
        GAS f32x4* o = (GAS f32x4*)(F.out + (size_t)row * D) + lane; const GAS v2u* fr_ = (const GAS v2u*)(F.FF + (size_t)row * D) + lane; const float* mod = F.MOD + mod_idx(row) * NMOD;
        f32x4 v[4], x[4]; float s = 0.f;
#pragma unroll
        for (int j = 0; j < 4; ++j) { const v2u fw = fr_[64 * j]; v[j] = (f32x4){bflo(fw.x), bfhi(fw.x), bflo(fw.y), bfhi(fw.y)}; x[j] = o[64 * j]; s += (v[j].x * v[j].x + v[j].y * v[j].y) + (v[j].z * v[j].z + v[j].w * v[j].w); }
        const float r = rsqrtf(wave_sum(s) * (1.f / D) + EPS);
#pragma unroll
        for (int j = 0; j < 4; ++j) { const int col = 256 * j + 4 * lane;
            const f32x4 gp = *(const GAS f32x4*)(F.g_ffn_post + col), g2 = *(const GAS f32x4*)(mod + 5 * D + col);
            o[64 * j] = x[j] + g2 * (v[j] * r * gp); }
    }
}

struct Args { const float* in[24]; float* out; unsigned char* ws; int ph_lo, ph_hi; };
static_assert(sizeof(Args) == 26 * 8 + 8, "Args has no padding");
__global__ void __launch_bounds__(NWAVES * 64, 2) mega_fwd(Args args) {
    extern __shared__ __attribute__((aligned(16))) unsigned char lds[];
    Frame F;
    F.lds = (LAS unsigned char*)lds;
    F.MISC = (volatile LAS unsigned*)(F.lds + MISC_OFF);
    F.tid = threadIdx.x; F.lane = F.tid & 63; F.wave = __builtin_amdgcn_readfirstlane(F.tid >> 6);
    F.G = gridDim.x; { const int bx = blockIdx.x; F.vcu = (F.G % 8 == 0) ? (bx % 8) * (F.G / 8) + bx / 8 : bx; }
    unsigned char* ws = args.ws;
    F.ctl = (gu32*)(ws + WS_CTL);
    F.xp = args.in[0]; F.xs = args.in[1]; F.c = args.in[2]; F.state = args.in[3]; F.cctx = args.in[4]; F.wmod = args.in[5]; F.bmod = args.in[6];
    F.g_mix_pre = args.in[7]; F.g_mix_post = args.in[8]; F.g_ffn_pre = args.in[9]; F.g_ffn_post = args.in[10]; F.w_in = args.in[11]; F.w_pool = args.in[12]; F.pscale = args.in[13];
    F.convw = args.in[14]; F.convb = args.in[15]; F.wa = args.in[16]; F.ba = args.in[17]; F.wx = args.in[18]; F.bx = args.in[19]; F.lam = args.in[20];
    F.w_out = args.in[21]; F.w_fi = args.in[22]; F.w_fo = args.in[23];
    F.out = args.out; F.newstate = args.out + (size_t)M * D;
    F.MOD = (float*)(ws + WS_MOD);
    F.Win_t = (bf16*)(ws + WS_WIN); F.Wout_t = (bf16*)(ws + WS_WOUT); F.Wfi_t = (bf16*)(ws + WS_WFI); F.Wfo_t = (bf16*)(ws + WS_WFO); F.Wcat = (bf16*)(ws + WS_WCAT); F.Wpt = (bf16*)(ws + WS_WPT);
    F.LSC = (float*)(ws + WS_LSC); F.CAGG = (f32x2*)(ws + WS_CAGG);
    F.XN = (bf16*)(ws + WS_XN); F.MIX = (bf16*)(ws + WS_XN); F.H2 = (bf16*)(ws + WS_XN); F.FF = (bf16*)(ws + WS_FF);
    F.U = (bf16*)(ws + WS_U); F.MIXO = (bf16*)(ws + WS_U); F.ACT = (bf16*)(ws + WS_ACT);
    for (int u = F.tid; u < (LDS_BYTES - MISC_OFF) / 4; u += NWAVES * 64) ((LAS unsigned*)(F.lds + MISC_OFF))[u] = 0u;
    __syncthreads();
    const int lo = args.ph_lo, hi = args.ph_hi;
    XcdBarrier bar; bar.bar = (unsigned*)(F.ctl + CW_BAR); bar.x = 0; bar.st = nullptr;
    if (hi - lo > 1) bar = xcd_barrier_post((unsigned*)(F.ctl + CW_BAR), F.MISC + 8);
#ifndef PH_MASK
#define PH_MASK 0x3ff
#endif
#define IN(k) (((PH_MASK >> (k)) & 1) && lo <= (k) && (k) < hi)
#define SEAM(k) do { if (IN(k) && IN((k) + 1)) xcd_barrier(bar); } while (0)
#ifndef PROBE_REPEAT
#define PROBE_REPEAT 0
#endif
#define REPS(k) for (int rep_ = 0; rep_ <= ((PROBE_REPEAT >> (k)) & 1); ++rep_, (rep_ <= ((PROBE_REPEAT >> (k)) & 1) ? xcd_barrier(bar) : (void)0))

    if (IN(0)) REPS(0) { p0_prologue(F); } SEAM(0);
    if (IN(1)) REPS(1) { p1_xn(F); } SEAM(1);
    if (IN(2)) REPS(2) {
        pg8::Gemm g{F.XN, F.Win_t, M, NIN, D}; pg8::StaticOrder S; S.init(M, NIN, F.G, (int)blockIdx.x);
        pg8::EpiBf16<0> E{F.U, NIN, nullptr, 0, 0, 1.f};
        pg8::gemm_phase<pg8::EpiBf16<0>, pg8::StaticOrder, true, true>(F.lds + RING_OFF, g, S, E);
    } SEAM(2);
    if (IN(3)) REPS(3) {
        lru_units<false>(F, NCH_P, NCH_S * 2 * NHEAD);
        pool_units(F, NCH_S * 2 * NHEAD, (M / 128) * 4);
    } SEAM(3);
    if (IN(4)) REPS(4) {
        lru_units<true>(F, 0, NCH * 2 * NHEAD);
    } SEAM(4);
    if (IN(5)) REPS(5) {
        pg8::Gemm g{F.MIX, F.Wout_t, M, D, D}; pg8::StaticOrder S; S.init(M, D, F.G, (int)blockIdx.x);
        pg8::EpiBf16<0> E{F.MIXO, D, nullptr, 0, 0, 1.f};
        pg8::gemm_phase<pg8::EpiBf16<0>, pg8::StaticOrder, true, true>(F.lds + RING_OFF, g, S, E);
    } SEAM(5);
    if (IN(6)) REPS(6) { p6_rows(F); } SEAM(6);
    if (IN(7)) REPS(7) {
        pg8::Gemm g{F.H2, F.Wfi_t, M, 2 * DFF, D}; pg8::StaticOrder S; S.init(M, 2 * DFF, F.G, (int)blockIdx.x);
        pg8::EpiSwiglu E{F.ACT, DFF};
        pg8::gemm_phase<pg8::EpiSwiglu, pg8::StaticOrder, true, true>(F.lds + RING_OFF, g, S, E);
    } SEAM(7);
    if (IN(8)) REPS(8) {
        pg8::Gemm g{F.ACT, F.Wfo_t, M, D, DFF}; pg8::StaticOrder S; S.init(M, D, F.G, (int)blockIdx.x);
        pg8::EpiBf16<0> E{F.FF, D, nullptr, 0, 0, 1.f};
        pg8::gemm_phase<pg8::EpiBf16<0>, pg8::StaticOrder, true, true>(F.lds + RING_OFF, g, S, E);
    } SEAM(8);
    if (IN(9)) REPS(9) { p9_rows(F); }
#undef IN
#undef SEAM
}

extern "C" void kernel_launch(void* const* d_in, const int* in_sizes, int n_in, void* d_out, int out_size, void* d_ws, size_t ws_size, hipStream_t stream) {
    static int grid = 0;
    if (grid == 0) {
        if (n_in != 24 || in_sizes[0] != MP * D || in_sizes[1] != MS * D || out_size != M * D + NB * 2 * LW || ws_size < WS_END) {
            fprintf(stderr, "kernel_launch: unexpected shapes: n_in %d, in0 %d, in1 %d, out %d, ws %zu; nothing launched\n", n_in, n_in > 0 ? in_sizes[0] : -1, n_in > 1 ? in_sizes[1] : -1, out_size, ws_size); grid = -1; return; }
        int dev = 0, cus = 0, per_cu = 0;
        if (hipGetDevice(&dev) != hipSuccess || hipDeviceGetAttribute(&cus, hipDeviceAttributeMultiprocessorCount, dev) != hipSuccess) { fprintf(stderr, "kernel_launch: device query failed\n"); grid = -1; return; }
        if (hipFuncSetAttribute((const void*)mega_fwd, hipFuncAttributeMaxDynamicSharedMemorySize, LDS_BYTES) != hipSuccess) { fprintf(stderr, "kernel_launch: hipFuncSetAttribute failed\n"); grid = -1; return; }
        if (hipOccupancyMaxActiveBlocksPerMultiprocessor(&per_cu, (const void*)mega_fwd, NWAVES * 64, LDS_BYTES) != hipSuccess || per_cu < 1) {
            fprintf(stderr, "kernel_launch: occupancy query reports %d workgroups per CU: the grid cannot be resident; nothing launched\n", per_cu); (void)hipGetLastError(); grid = -1; return; }
        grid = cus;
    }
    if (grid < 0) return;
    if (hipMemsetAsync((char*)d_ws + WS_CTL, 0, CTL_ZERO_BYTES, stream) != hipSuccess) { fprintf(stderr, "kernel_launch: hipMemsetAsync failed\n"); return; }
    Args a{};
    for (int i = 0; i < 24; ++i) a.in[i] = (const float*)d_in[i];
    a.out = (float*)d_out; a.ws = (unsigned char*)d_ws;
#if MK_ONE_LAUNCH
    a.ph_lo = 0; a.ph_hi = N_PHASES;
    hipLaunchKernelGGL(mega_fwd, dim3(grid), dim3(NWAVES * 64), LDS_BYTES, stream, a);
#else
    for (int p = 0; p < N_PHASES; ++p) { a.ph_lo = p; a.ph_hi = p + 1; hipLaunchKernelGGL(mega_fwd, dim3(grid), dim3(NWAVES * 64), LDS_BYTES, stream, a); }
#endif
    const hipError_t le = hipPeekAtLastError();
    if (le != hipSuccess) fprintf(stderr, "kernel_launch: launch failed: %s (grid %d x %d threads, %d B LDS)\n", hipGetErrorName(le), grid, NWAVES * 64, LDS_BYTES);
}
```

```cpp
#include <hip/hip_runtime.h>
#include <cstdio>
#include <cstdint>
namespace pg8 {
#define PG8_LAS __attribute__((address_space(3)))
typedef unsigned short bf16_t;
typedef short bf16x8 __attribute__((ext_vector_type(8)));
typedef float f32x4 __attribute__((ext_vector_type(4)));
typedef unsigned u32x4 __attribute__((ext_vector_type(4)));
constexpr int BM = 256, BK = 64, HALF = 128, HTB = HALF * BK * 2  , STAGE_BYTES = 8 * HTB, NXCD = 8, WGM = 8;
#ifndef PG8_MA
#define PG8_MA 3
#endif
constexpr int MA = PG8_MA, HALF_A = 32 * MA, BMR = 2 * HALF_A;

__host__ __device__ __forceinline__ int lds_byte(int r, int c) { const int st = (r >> 4) * 2 + (c >> 5), rr = r & 15, cc = c & 31, ob = rr * 64 + cc * 2; return st * 1024 + (ob ^ (((ob >> 9) & 1) << 5)); }
__host__ __device__ __forceinline__ void stage_rc(int b, int& R, int& C) { const int st = b / 1024, sb = b % 1024, swz = sb ^ (((sb >> 9) & 1) << 5); R = (st >> 1) * 16 + swz / 64; C = (st & 1) * 32 + (swz % 64) / 2; }
__host__ __device__ __forceinline__ int perm32(int rho) { const int n = rho >> 4, i = rho & 15; return 8 * (i >> 2) + 4 * n + (i & 3); }

struct Unit { int pm, pn; };
struct Gemm { const bf16_t* A; const bf16_t* Bt; int M, N, K; };

struct StaticOrder {
    int nM, nN, nwg, G, c;
    __host__ __device__ void init(int M, int N, int G_, int c_) { nM = M / BMR; nN = N / BM; nwg = nM * nN; G = G_; c = c_; }
    __host__ __device__ bool next(int i, Unit& u) const {
        const long L = (long)i * G + c; if (L >= nwg) return false;
        int wgid = (int)L; { const int q = nwg / NXCD, r = nwg % NXCD, xcd = wgid % NXCD, off = wgid / NXCD; wgid = (xcd < r ? xcd * (q + 1) : r * (q + 1) + (xcd - r) * q) + off; }
        const int nig = WGM * nN, gid = wgid / nig, fm = gid * WGM, gsz = (nM - fm) < WGM ? (nM - fm) : WGM;
        u.pm = fm + ((wgid % nig) % gsz); u.pn = (wgid % nig) / gsz; return true;
    }
    __device__ __forceinline__ void a_ready(const Unit&) const {}
    __device__ __forceinline__ void done(const Unit&) const {}
};

__device__ __forceinline__ unsigned cvt_pk_bf16(float lo, float hi) { unsigned r; asm volatile("v_cvt_pk_bf16_f32 %0, %1, %2" : "=v"(r) : "v"(lo), "v"(hi)); return r; }
typedef float f32x2 __attribute__((ext_vector_type(2)));
__device__ __forceinline__ f32x2 gelu_pk(f32x2 v) {
    const f32x2 av = __builtin_elementwise_abs(v), d = av * 0.2316418882f + 1.0f;
    f32x2 t; t.x = __builtin_amdgcn_rcpf(d.x); t.y = __builtin_amdgcn_rcpf(d.y);
    f32x2 q = t * 0.5307027145f + (-0.7265760135f); q = q * t + 0.7107068705f; q = q * t + (-0.142248368f); q = q * t + 0.127414796f; q = q * t;
    const f32x2 s = (v * v) * (-0.72134752044f);
    f32x2 e; e.x = __builtin_amdgcn_exp2f(s.x); e.y = __builtin_amdgcn_exp2f(s.y);
    const f32x2 m = v * (q * e), r = v - m;
    f32x2 o; o.x = v.x < 0.f ? m.x : r.x; o.y = v.y < 0.f ? m.y : r.y; return o;
}

template <int ACT  > struct EpiBf16 {
    static constexpr bool PERM = true, AFTER_DRAIN = false; static_assert(ACT == 0 || ACT == 1, "EpiBf16: ACT is 0 (none) or 1 (gelu_pk)");
    bf16_t* O; int ldc; const float* bias; int split_cols; size_t split_stride; float scale0;
    __device__ __forceinline__ void operator()(const f32x4 (&acc)[2][2][MA][2], const Unit& u, int wr, int wc, int fr, int fq) const {
        const int row0 = u.pm * BMR + wr * (HALF_A / 2) + fr; int colt = u.pn * BM; bf16_t* base = O;
        float sc = 1.f; if (split_cols) { const int t = colt / split_cols; base += (size_t)t * split_stride; colt -= t * split_cols; if (t == 0) sc = scale0; }
        const int col0 = colt + wc * 32 + 8 * fq, bcol0 = u.pn * BM + wc * 32 + 8 * fq;
        f32x4 bv[2][2];
#pragma unroll
        for (int bj = 0; bj < 2; ++bj)
#pragma unroll
            for (int n = 0; n < 2; ++n) bv[bj][n] = bias ? *(const f32x4*)(bias + bcol0 + bj * HALF + 4 * n) : (f32x4){0.f, 0.f, 0.f, 0.f};
#pragma unroll
        for (int ai = 0; ai < 2; ++ai)
#pragma unroll
            for (int m = 0; m < MA; ++m) { bf16_t* rowp = base + (size_t)(row0 + ai * HALF_A + m * 16) * ldc + col0;
#pragma unroll
                for (int bj = 0; bj < 2; ++bj) { f32x4 v0 = acc[ai][bj][m][0] + bv[bj][0], v1 = acc[ai][bj][m][1] + bv[bj][1];
                    if (ACT == 1) { f32x2 a = gelu_pk((f32x2){v0[0], v0[1]}), b = gelu_pk((f32x2){v0[2], v0[3]}), c = gelu_pk((f32x2){v1[0], v1[1]}), d = gelu_pk((f32x2){v1[2], v1[3]});
                        v0 = (f32x4){a.x, a.y, b.x, b.y}; v1 = (f32x4){c.x, c.y, d.x, d.y}; }
                    v0 = v0 * sc; v1 = v1 * sc; u32x4 w; w.x = cvt_pk_bf16(v0[0], v0[1]); w.y = cvt_pk_bf16(v0[2], v0[3]); w.z = cvt_pk_bf16(v1[0], v1[1]); w.w = cvt_pk_bf16(v1[2], v1[3]);
                    *(u32x4*)(rowp + bj * HALF) = w; } }
    }
};
struct EpiF32 {
    static constexpr bool PERM = false, AFTER_DRAIN = false;
    float* C; int ldc;
    __device__ __forceinline__ void operator()(const f32x4 (&acc)[2][2][MA][2], const Unit& u, int wr, int wc, int fr, int fq) const {
        const int row0 = u.pm * BMR + wr * (HALF_A / 2) + fr, col0 = u.pn * BM + wc * 32 + 4 * fq;
#pragma unroll
        for (int ai = 0; ai < 2; ++ai)
#pragma unroll
            for (int m = 0; m < MA; ++m) { float* rowp = C + (size_t)(row0 + ai * HALF_A + m * 16) * ldc + col0;
#pragma unroll
                for (int bj = 0; bj < 2; ++bj)
#pragma unroll
                    for (int n = 0; n < 2; ++n) *(f32x4*)(rowp + bj * HALF + n * 16) = acc[ai][bj][m][n]; }
    }
};
struct EpiSwiglu {
    static constexpr bool PERM = true, AFTER_DRAIN = false;
    bf16_t* O; int ldc;
    __device__ __forceinline__ void operator()(const f32x4 (&acc)[2][2][MA][2], const Unit& u, int wr, int wc, int fr, int fq) const {
        const int row0 = u.pm * BMR + wr * (HALF_A / 2) + fr, col0 = u.pn * HALF + wc * 32 + 8 * fq;
#pragma unroll
        for (int ai = 0; ai < 2; ++ai)
#pragma unroll
            for (int m = 0; m < MA; ++m) { bf16_t* rowp = O + (size_t)(row0 + ai * HALF_A + m * 16) * ldc + col0;
                float o[8];
#pragma unroll
                for (int n = 0; n < 2; ++n)
#pragma unroll
                    for (int e = 0; e < 4; ++e) { const float g = acc[ai][0][m][n][e], up = acc[ai][1][m][n][e];
                        o[4 * n + e] = g * __builtin_amdgcn_rcpf(1.0f + __builtin_amdgcn_exp2f(-1.4426950408889634f * g)) * up; }
                u32x4 w; w.x = cvt_pk_bf16(o[0], o[1]); w.y = cvt_pk_bf16(o[2], o[3]); w.z = cvt_pk_bf16(o[4], o[5]); w.w = cvt_pk_bf16(o[6], o[7]);
                *(u32x4*)rowp = w; }
    }
};

template <class Epi, class Sched, bool ALIGN_EPI = false, bool SP2 = false>
__device__ __forceinline__ void gemm_phase(PG8_LAS unsigned char* lds, const Gemm g, const Sched& S, const Epi& E) {
    const int tid = threadIdx.x, wid = __builtin_amdgcn_readfirstlane(tid >> 6), lane = tid & 63, wr = wid >> 2, wc = wid & 3, fr = lane & 15, fq = lane >> 4;
    const int K = g.K, nt = K / BK;
    unsigned voffA[2], voffB[2];
#pragma unroll
    for (int i = 0; i < 2; ++i) { int R, C; stage_rc(tid * 16 + i * 8192, R, C); const int Rb = Epi::PERM ? ((R & ~31) + perm32(R & 31)) : R;
        const int Ra = R < HALF_A ? R : R - 32;
        voffA[i] = (unsigned)(Ra * K + C) * 2u; voffB[i] = (unsigned)(Rb * K + C) * 2u; }
    const size_t kstep = (size_t)(BK * 2);
    const size_t hstepA = (size_t)HALF_A * K * 2, hstepB = (size_t)HALF * K * 2;
    const size_t tstepA = 2 * hstepA, tstepB = 2 * hstepB;
    const unsigned ldsw = (unsigned)wid * 1024u;
    const int aoff = lds_byte(wr * (HALF_A / 2) + fr, fq * 8), boff = lds_byte(wc * 32 + fr, fq * 8);
#define PG8_SA(b, h) (((b) * 2 + (h)) * HTB)
#define PG8_SB(b, h) ((4 + (b) * 2 + (h)) * HTB)
#define PG8_STAGE(bufoff, gbase, voff) do { _Pragma("unroll") for (int _i = 0; _i < 2; ++_i) \
        __builtin_amdgcn_global_load_lds((const unsigned*)((const char*)(gbase) + (voff)[_i]), (PG8_LAS unsigned*)(lds + (bufoff) + ldsw + _i * 8192), 16, 0, 0); } while (0)
#define PG8_LDA(dst, b, h) do { _Pragma("unroll") for (int m = 0; m < MA; ++m) _Pragma("unroll") for (int k = 0; k < 2; ++k) dst[m][k] = *(const PG8_LAS bf16x8*)(lds + PG8_SA(b, h) + aoff + m * 2048 + k * 1024); } while (0)
#define PG8_LDB(dst, b, h) do { _Pragma("unroll") for (int n = 0; n < 2; ++n) _Pragma("unroll") for (int k = 0; k < 2; ++k) dst[n][k] = *(const PG8_LAS bf16x8*)(lds + PG8_SB(b, h) + boff + n * 2048 + k * 1024); } while (0)
#define PG8_MMA(ai, bj, At, Bt) do { __builtin_amdgcn_s_setprio(1); _Pragma("unroll") for (int m = 0; m < MA; ++m) _Pragma("unroll") for (int n = 0; n < 2; ++n) _Pragma("unroll") for (int k = 0; k < 2; ++k) \
        acc[ai][bj][m][n] = __builtin_amdgcn_mfma_f32_16x16x32_bf16(Bt[n][k], At[m][k], acc[ai][bj][m][n], 0, 0, 0); __builtin_amdgcn_s_setprio(0); } while (0)
#define PG8_WAIT_V(n) asm volatile("s_waitcnt vmcnt(" #n ")" ::: "memory")
#define PG8_WAIT_L(n) asm volatile("s_waitcnt lgkmcnt(" #n ")" ::: "memory")
#define PG8_BAR __builtin_amdgcn_s_barrier()
#define PG8_SCHED __builtin_amdgcn_sched_barrier(0)
    Unit cur, nxt; int ui = 0;
    if (!S.next(0, cur)) return;
    f32x4 acc[2][2][MA][2];
#pragma unroll
    for (int a = 0; a < 2; ++a)
#pragma unroll
        for (int b = 0; b < 2; ++b)
#pragma unroll
            for (int m = 0; m < MA; ++m)
#pragma unroll
                for (int n = 0; n < 2; ++n) acc[a][b][m][n] = (f32x4){0.f, 0.f, 0.f, 0.f};
    bf16x8 At[MA][2], B0[2][2], B1[2][2];
    const char* cA = (const char*)g.A + (size_t)cur.pm * tstepA; const char* cB = (const char*)g.Bt + (size_t)cur.pn * tstepB;
    S.a_ready(cur);
    if constexpr (SP2) {
        PG8_STAGE(PG8_SB(0, 0), cB, voffB); PG8_STAGE(PG8_SB(0, 1), cB + hstepB, voffB); PG8_STAGE(PG8_SA(0, 0), cA, voffA); PG8_STAGE(PG8_SA(0, 1), cA + hstepA, voffA);
        if (wr == 1) PG8_BAR;
        PG8_WAIT_V(2); PG8_BAR;
        PG8_STAGE(PG8_SB(1, 0), cB + kstep, voffB); PG8_STAGE(PG8_SA(1, 0), cA + kstep, voffA); PG8_STAGE(PG8_SB(1, 1), cB + hstepB + kstep, voffB);
        PG8_WAIT_V(6); PG8_BAR;
    } else {
        PG8_STAGE(PG8_SB(0, 0), cB, voffB); PG8_STAGE(PG8_SA(0, 0), cA, voffA); PG8_STAGE(PG8_SB(0, 1), cB + hstepB, voffB); PG8_STAGE(PG8_SA(0, 1), cA + hstepA, voffA);
        if (wr == 1) PG8_BAR;
        PG8_WAIT_V(4); PG8_BAR;
        PG8_STAGE(PG8_SB(1, 0), cB + kstep, voffB); PG8_STAGE(PG8_SA(1, 0), cA + kstep, voffA); PG8_STAGE(PG8_SB(1, 1), cB + hstepB + kstep, voffB);
        PG8_WAIT_V(6); PG8_BAR;
    }
    for (;;) {
        const bool has_next = S.next(ui + 1, nxt);
        const char* nA = has_next ? (const char*)g.A + (size_t)nxt.pm * tstepA : cA; const char* nB = has_next ? (const char*)g.Bt + (size_t)nxt.pn * tstepB : cB;
        for (int t = 0; t < nt; t += 2) {
            const bool last = (t == nt - 2);
            const char* a1 = cA + (size_t)(t + 1) * kstep;
            const char* a2 = last ? nA : cA + (size_t)(t + 2) * kstep; const char* b2 = last ? nB : cB + (size_t)(t + 2) * kstep;
            const char* a3 = a2 + kstep; const char* b3 = b2 + kstep;
            if (last && has_next) S.a_ready(nxt);
            if constexpr (SP2) {
            PG8_LDB(B0, 0, 0); PG8_LDB(B1, 0, 1); PG8_SCHED; PG8_LDA(At, 0, 0); PG8_STAGE(PG8_SA(1, 1), a1 + hstepA, voffA);
            PG8_WAIT_V(8); PG8_WAIT_L(0); PG8_BAR; PG8_MMA(0, 0, At, B0); PG8_MMA(0, 1, At, B1); PG8_BAR; PG8_SCHED;
            PG8_LDA(At, 0, 1); PG8_STAGE(PG8_SB(0, 0), b2, voffB); PG8_STAGE(PG8_SB(0, 1), b2 + hstepB, voffB); PG8_STAGE(PG8_SA(0, 0), a2, voffA);
            PG8_WAIT_V(8); PG8_WAIT_L(0); PG8_BAR; PG8_MMA(1, 0, At, B0); PG8_MMA(1, 1, At, B1); PG8_BAR; PG8_SCHED;
            PG8_LDB(B0, 1, 0); PG8_LDB(B1, 1, 1); PG8_SCHED; PG8_LDA(At, 1, 0); PG8_STAGE(PG8_SA(0, 1), a2 + hstepA, voffA);
            PG8_WAIT_V(8); PG8_WAIT_L(0); PG8_BAR; PG8_MMA(0, 0, At, B0); PG8_MMA(0, 1, At, B1); PG8_BAR; PG8_SCHED;
            PG8_LDA(At, 1, 1); PG8_STAGE(PG8_SB(1, 0), b3, voffB); PG8_STAGE(PG8_SB(1, 1), b3 + hstepB, voffB); PG8_STAGE(PG8_SA(1, 0), a3, voffA);
            PG8_WAIT_V(8); PG8_WAIT_L(0); PG8_BAR; PG8_MMA(1, 0, At, B0); PG8_MMA(1, 1, At, B1); PG8_BAR; PG8_SCHED;
            } else {
            PG8_LDB(B0, 0, 0); PG8_SCHED; PG8_LDA(At, 0, 0); PG8_STAGE(PG8_SA(1, 1), a1 + hstepA, voffA);
            PG8_WAIT_L(8); PG8_BAR; PG8_WAIT_L(0); PG8_MMA(0, 0, At, B0); PG8_BAR; PG8_SCHED;
            PG8_LDB(B1, 0, 1); PG8_STAGE(PG8_SB(0, 0), b2, voffB);
            PG8_BAR; PG8_WAIT_L(0); PG8_MMA(0, 1, At, B1); PG8_BAR;
            PG8_LDA(At, 0, 1); PG8_STAGE(PG8_SA(0, 0), a2, voffA);
            PG8_BAR; PG8_WAIT_L(0); PG8_MMA(1, 0, At, B0); PG8_BAR; PG8_SCHED;
            PG8_STAGE(PG8_SB(0, 1), b2 + hstepB, voffB);
            PG8_WAIT_V(6); PG8_BAR; PG8_MMA(1, 1, At, B1); PG8_BAR;
            PG8_LDB(B0, 1, 0); PG8_SCHED; PG8_LDA(At, 1, 0); PG8_STAGE(PG8_SA(0, 1), a2 + hstepA, voffA);
            PG8_WAIT_L(8); PG8_BAR; PG8_WAIT_L(0); PG8_MMA(0, 0, At, B0); PG8_BAR; PG8_SCHED;
            PG8_LDB(B1, 1, 1); PG8_STAGE(PG8_SB(1, 0), b3, voffB);
            PG8_BAR; PG8_WAIT_L(0); PG8_MMA(0, 1, At, B1); PG8_BAR;
            PG8_LDA(At, 1, 1); PG8_STAGE(PG8_SA(1, 0), a3, voffA);
            PG8_BAR; PG8_WAIT_L(0); PG8_MMA(1, 0, At, B0); PG8_BAR; PG8_SCHED;
            PG8_STAGE(PG8_SB(1, 1), b3 + hstepB, voffB);
            PG8_WAIT_V(6); PG8_BAR; PG8_MMA(1, 1, At, B1); PG8_BAR;
            }
        }
        if constexpr (ALIGN_EPI) { if (wr == 0) PG8_BAR; }
        if constexpr (!Epi::AFTER_DRAIN) { E(acc, cur, wr, wc, fr, fq); S.done(cur); }
        if (!has_next) break;
#pragma unroll
        for (int a = 0; a < 2; ++a)
#pragma unroll
            for (int b = 0; b < 2; ++b)
#pragma unroll
                for (int m = 0; m < MA; ++m)
#pragma unroll
                    for (int n = 0; n < 2; ++n) acc[a][b][m][n] = (f32x4){0.f, 0.f, 0.f, 0.f};
        cur = nxt; cA = nA; cB = nB; ++ui;
        if constexpr (ALIGN_EPI) { if (wr == 1) PG8_BAR; }
    }
    PG8_WAIT_V(0);
    if constexpr (!ALIGN_EPI) { if (wr == 0) PG8_BAR; }
    PG8_BAR;
    if constexpr (Epi::AFTER_DRAIN) { E.fused(acc, cur, wr, wc, fr, fq, lds, wid, lane); S.done(cur); }
#undef PG8_SA
#undef PG8_SB
#undef PG8_STAGE
#undef PG8_LDA
#undef PG8_LDB
#undef PG8_MMA
#undef PG8_WAIT_V
#undef PG8_WAIT_L
#undef PG8_BAR
#undef PG8_SCHED
}
}

constexpr int NWAVES = 8;
#ifndef MK_ONE_LAUNCH
#define MK_ONE_LAUNCH 1
#endif
constexpr int N_PHASES = 10;

constexpr int D = 1024, NB = 32, SEQ = 256, DB = 4, DSEQ = 4096, GRIDW = 64;
constexpr int MP = NB * SEQ, MS = DB * DSEQ, M = MP + MS;
constexpr int NIN = 1536, PW = 512, LW = 512, DFF = 2816, NMOD = 6 * D, NHEAD = 8, HD = 64;
constexpr int NCH = M / 256, NCH_P = MP / 256, NCH_S = MS / 256;
constexpr float EPS = 1e-6f;

constexpr size_t MiB = 1u << 20, KiB = 1u << 10;
constexpr size_t WS_CTL = 0, CTL_ZERO_BYTES = 1 * MiB;
constexpr size_t WS_MOD = 64 * KiB;
constexpr size_t WS_WIN = 1 * MiB, WS_WOUT = 4 * MiB, WS_WFI = 6 * MiB, WS_WFO = 17 * MiB;
constexpr size_t WS_WCAT = 23 * MiB, WS_WPT = WS_WCAT + 256 * KiB, WS_LSC = WS_WPT + 128 * KiB, WS_CAGG = WS_WCAT + 512 * KiB;
constexpr size_t WS_XN = 24 * MiB;
constexpr size_t WS_U = 72 * MiB;
constexpr size_t WS_FF = 72 * MiB;
constexpr size_t WS_ACT = 124 * MiB;
constexpr size_t WS_END = 256 * MiB;
static_assert(WS_WFO + (size_t)D * DFF * 2 <= WS_WCAT && WS_CAGG + (size_t)NCH_S * 2 * LW * 8 <= WS_XN && WS_ACT + (size_t)M * DFF * 2 <= WS_END && WS_MOD + 5 * NMOD * 4 <= CTL_ZERO_BYTES, "d_ws map");
constexpr int CW_BAR = 4096;

constexpr int LDS_BYTES = 147456;
constexpr int MISC_OFF = LDS_BYTES - 256;
constexpr int RING_OFF = 0;

#define GAS __attribute__((address_space(1)))
#define LAS __attribute__((address_space(3)))
typedef unsigned short bf16;
typedef unsigned v4u __attribute__((ext_vector_type(4)));
typedef unsigned v2u __attribute__((ext_vector_type(2)));
typedef float f32x4 __attribute__((ext_vector_type(4)));
typedef float f32x2 __attribute__((ext_vector_type(2)));
typedef short bf16x8 __attribute__((ext_vector_type(8)));
typedef GAS unsigned gu32;
typedef GAS unsigned long long gu64;
#define RLX_AGENT __ATOMIC_RELAXED, __HIP_MEMORY_SCOPE_AGENT
#define LDS_WAIT() asm volatile("s_waitcnt lgkmcnt(0)" ::: "memory")
#define VM_WAIT() asm volatile("s_waitcnt vmcnt(0)" ::: "memory")
__device__ __forceinline__ unsigned f2bf(float f) { unsigned u = __builtin_bit_cast(unsigned, f); return (u + 0x7fffu + ((u >> 16) & 1u)) >> 16; }
__device__ __forceinline__ unsigned pk2(float lo, float hi) { unsigned r; asm("v_cvt_pk_bf16_f32 %0, %1, %2" : "=v"(r) : "v"(lo), "v"(hi)); return r; }
#define RAW_BARRIER() do { asm volatile("s_waitcnt lgkmcnt(0)" ::: "memory"); __builtin_amdgcn_s_barrier(); asm volatile("" ::: "memory"); } while (0)
__device__ __forceinline__ float bflo(unsigned w) { return __builtin_bit_cast(float, w << 16); }
__device__ __forceinline__ float bfhi(unsigned w) { return __builtin_bit_cast(float, w & 0xffff0000u); }
__device__ __forceinline__ float fsigmoid(float z) { return __builtin_amdgcn_rcpf(1.0f + __builtin_amdgcn_exp2f(-1.4426950408889634f * z)); }

#define XB_TMO      128
#define XB_XCNT(j)  (256  + 64 * (j))
#define XB_XSUB(j)  (1280 + 64 * (j))
#define XB_XGEN(j)  (2304 + 64 * (j))
#define XB_TOP      3328
#define XB_TOPGEN   3392
#define XCD_BAR_WORDS 3456
#define XB_SPIN_CAP (1u << 18)

__device__ __forceinline__ unsigned xb_ld(unsigned* p)              { return __hip_atomic_load(p, __ATOMIC_RELAXED, __HIP_MEMORY_SCOPE_AGENT); }
__device__ __forceinline__ unsigned xb_add(unsigned* p, unsigned v) { return __hip_atomic_fetch_add(p, v, __ATOMIC_RELAXED, __HIP_MEMORY_SCOPE_AGENT); }
__device__ __forceinline__ unsigned xb_xcc_id() { return (unsigned)__builtin_amdgcn_s_getreg((3 << 11) | 20) & 0xFu; }
#define XB_SPIN(cond, bar) do { unsigned _sp = 0; while (cond) { __builtin_amdgcn_s_sleep(1); \
    if ((++_sp & 255u) == 0u) { if (xb_ld(&(bar)[XB_TMO])) break; if (_sp > XB_SPIN_CAP) { atomicAdd(&(bar)[XB_TMO], 1u); break; } } } } while (0)

struct XcdBarrier {
    unsigned* bar; unsigned x;
    volatile LAS unsigned* st;
};

__device__ __forceinline__ XcdBarrier xcd_barrier_post(unsigned* bar, volatile LAS unsigned* st) {
    XcdBarrier b; b.bar = bar; b.x = xb_xcc_id(); b.st = st;
    if (threadIdx.x == 0) (void)xb_add(&bar[XB_XCNT(b.x)], 1u);
    return b;
}
__device__ __forceinline__ void xcd_barrier_complete(unsigned* bar, unsigned x, unsigned& nloc, unsigned& nx) {
    const unsigned G = gridDim.x * gridDim.y * gridDim.z;
    unsigned sum, cnt, mine, sp = 0u;
    for (;;) {
        sum = 0u; cnt = 0u; mine = 0u;
#pragma unroll
        for (unsigned j = 0; j < 16; ++j) { const unsigned c = xb_ld(&bar[XB_XCNT(j)]); sum += c; cnt += (c > 0u) ? 1u : 0u; mine = (j == x) ? c : mine; }
        if (sum == G) break;
        __builtin_amdgcn_s_sleep(1);
        if ((++sp & 255u) == 0u) { if (xb_ld(&bar[XB_TMO])) break; if (sp > XB_SPIN_CAP) { atomicAdd(&bar[XB_TMO], 1u); break; } }
    }
    nloc = mine > 0u ? mine : 1u; nx = cnt > 0u ? cnt : 1u;
}

__device__ __forceinline__ void xcd_barrier(const XcdBarrier& b) {
    asm volatile("s_waitcnt vmcnt(0)" ::: "memory");
    __syncthreads();
    if (threadIdx.x == 0) {
        unsigned* bar = b.bar;
        __builtin_amdgcn_s_waitcnt(0);
        unsigned nloc = b.st[0], nx = b.st[1];
        if (nloc == 0u) { xcd_barrier_complete(bar, b.x, nloc, nx); b.st[0] = nloc; b.st[1] = nx; }
        const unsigned old = xb_add(&bar[XB_XSUB(b.x)], 1u);
        const unsigned gen = old / nloc;
        if (old + 1u == (gen + 1u) * nloc) {
            __builtin_amdgcn_fence(__ATOMIC_RELEASE, "agent");
            asm volatile("s_waitcnt vmcnt(0)" ::: "memory");
            const unsigned og = xb_add(&bar[XB_TOP], 1u);
            const unsigned tg = og / nx;
            if (og + 1u == (tg + 1u) * nx) xb_add(&bar[XB_TOPGEN], 1u);
            else XB_SPIN(xb_ld(&bar[XB_TOPGEN]) == tg, bar);
            __builtin_amdgcn_fence(__ATOMIC_ACQUIRE, "agent");
            xb_add(&bar[XB_XGEN(b.x)], 1u);
            asm volatile("s_waitcnt vmcnt(0)" ::: "memory");
        } else {
            XB_SPIN(xb_ld(&bar[XB_XGEN(b.x)]) == gen, bar);
            __builtin_amdgcn_fence(__ATOMIC_ACQUIRE, "agent");
            asm volatile("s_waitcnt vmcnt(0)" ::: "memory");
        }
    }
    __syncthreads();
}

struct Frame {
    LAS unsigned char* lds;
    volatile LAS unsigned* MISC;
    gu32* ctl;
    int tid, lane, wave;
    int vcu, G;
    const float *xp, *xs, *c, *state, *cctx, *wmod, *bmod, *g_mix_pre, *g_mix_post, *g_ffn_pre, *g_ffn_post, *w_in, *w_pool, *pscale, *convw, *convb, *wa, *ba, *wx, *bx, *lam, *w_out, *w_fi, *w_fo;
    float* out; float* newstate;
    float* MOD;
    bf16 *Win_t, *Wout_t, *Wfi_t, *Wfo_t, *Wcat, *Wpt;
    float* LSC;
    f32x2* CAGG;
    bf16 *XN, *U, *MIX, *H2, *ACT;
    bf16 *MIXO, *FF;
};
__device__ __forceinline__ const float* xrow(const Frame& F, int row) { return row < MP ? F.xp + (size_t)row * D : F.xs + (size_t)(row - MP) * D; }
__device__ __forceinline__ int mod_idx(int row) { return row < MP ? 0 : 1 + (row - MP) / DSEQ; }
__device__ __forceinline__ float wave_sum(float v) {
#pragma unroll
    for (int o = 1; o < 64; o <<= 1) v += __shfl_xor(v, o);
    return v;
}

__device__ __forceinline__ void p0_transpose_item(const float* W, int K, int N, bf16* WT, int k0, int n0, int drow0, LAS float* scr, int lane) {
#pragma unroll 8
    for (int i = 0; i < 32; ++i) { const int kk = 2 * i + (lane >> 5); scr[kk * 33 + (lane & 31)] = W[(size_t)(k0 + kk) * N + n0 + (lane & 31)]; }
    LDS_WAIT(); asm volatile("" ::: "memory");
    const int c = lane & 7;
#pragma unroll
    for (int j = 0; j < 4; ++j) { const int n = (lane >> 3) + 8 * j; const LAS float* s = scr + (8 * c) * 33 + n;
        v4u o; o.x = pk2(s[0 * 33], s[1 * 33]); o.y = pk2(s[2 * 33], s[3 * 33]); o.z = pk2(s[4 * 33], s[5 * 33]); o.w = pk2(s[6 * 33], s[7 * 33]);
        *(GAS v4u*)(WT + (size_t)(drow0 + n) * K + k0 + 8 * c) = o; }
    LDS_WAIT(); asm volatile("" ::: "memory");
}
__device__ __forceinline__ void p0_prologue(Frame& F) {
    LAS float* scr = (LAS float*)(F.lds + RING_OFF + F.wave * 16384);
    const int gw = F.vcu * NWAVES + F.wave, NGW = F.G * NWAVES, lane = F.lane;
    constexpr int MOD_UNITS = (NMOD / 64) * (D / 64);
    for (int it = gw; it < MOD_UNITS; it += NGW) {
        const int cg = it % (NMOD / 64), ks = it / (NMOD / 64), col = cg * 64 + lane, k0 = ks * 64;
        float sv[5];
#pragma unroll
        for (int v = 0; v < 5; ++v) { const float x = v == 0 ? F.cctx[k0 + lane] : F.c[(v - 1) * D + k0 + lane]; sv[v] = x * fsigmoid(x); }
        float acc[5] = {0.f, 0.f, 0.f, 0.f, 0.f};
#pragma unroll 16
        for (int kk = 0; kk < 64; ++kk) { const float w = F.wmod[(size_t)(k0 + kk) * NMOD + col];
#pragma unroll
            for (int v = 0; v < 5; ++v) acc[v] += __shfl(sv[v], kk) * w; }
        const float bm = ks == 0 ? F.bmod[col] : 0.f;
#pragma unroll
        for (int v = 0; v < 5; ++v) atomicAdd(F.MOD + v * NMOD + col, acc[v] + bm);
    }
    constexpr int I_IN = (D / 64) * (NIN / 32), I_OUT = (D / 64) * (D / 32), I_FI = (D / 64) * (2 * DFF / 32), I_FO = (DFF / 64) * (D / 32);
    constexpr int NITEMS = I_IN + I_OUT + I_FI + I_FO;
    for (int it = gw; it < NITEMS; it += NGW) {
        int r = it;
        if (r < I_IN) { const int nblk = NIN / 32, kb = r / nblk, nb = r % nblk; p0_transpose_item(F.w_in, D, NIN, F.Win_t, 64 * kb, 32 * nb, 32 * nb, scr, lane); continue; } r -= I_IN;
        if (r < I_OUT) { const int nblk = D / 32, kb = r / nblk, nb = r % nblk; p0_transpose_item(F.w_out, D, D, F.Wout_t, 64 * kb, 32 * nb, 32 * nb, scr, lane); continue; } r -= I_OUT;
        if (r < I_FI) { const int nblk = 2 * DFF / 32, kb = r / nblk, nb = r % nblk, n0 = 32 * nb;
            const int up = n0 >= DFF ? 1 : 0, j0 = n0 - up * DFF, drow0 = 256 * (j0 / 128) + 128 * up + (j0 % 128);
            p0_transpose_item(F.w_fi, D, 2 * DFF, F.Wfi_t, 64 * kb, n0, drow0, scr, lane); continue; } r -= I_FI;
        { const int nblk = D / 32, kb = r / nblk, nb = r % nblk; p0_transpose_item(F.w_fo, DFF, D, F.Wfo_t, 64 * kb, 32 * nb, 32 * nb, scr, lane); }
    }
    const int gt = F.vcu * NWAVES * 64 + F.tid, NGT = F.G * NWAVES * 64;
    for (int e = gt; e < NHEAD * 256 * 64; e += NGT) { const int i = e & 63, col = (e >> 6) & 255, h = e >> 14, type = col >> 6, j = col & 63, d = type >> 1;
        const float* src = (type & 1) ? F.wx : F.wa; F.Wcat[e] = (bf16)f2bf(-1.4426950408889634f * src[((size_t)(d * NHEAD + h) * 64 + i) * 64 + j]); }
    for (int e = gt; e < 4 * 128 * 128; e += NGT) { const int c = e & 127, dd = (e >> 7) & 127, g = e >> 14; F.Wpt[e] = (bf16)f2bf(F.w_pool[(size_t)(g * 128 + c) * 128 + dd]); }
    for (int e = gt; e < 2 * LW; e += NGT) F.LSC[e] = -8.0f * 1.4426950408889634f * log1pf(expf(-F.lam[e]));
}

__device__ __forceinline__ void p1_xn(Frame& F) {
    const int gw = F.vcu * NWAVES + F.wave, NGW = F.G * NWAVES, lane = F.lane;
    for (int row = gw; row < M; row += NGW) {
        const GAS f32x4* xr = (const GAS f32x4*)xrow(F, row) + lane; const float* mod = F.MOD + mod_idx(row) * NMOD;
        f32x4 v[4]; float s = 0.f;
#pragma unroll
        for (int j = 0; j < 4; ++j) { v[j] = xr[64 * j]; s += (v[j].x * v[j].x + v[j].y * v[j].y) + (v[j].z * v[j].z + v[j].w * v[j].w); }
        const float r = rsqrtf(wave_sum(s) * (1.f / D) + EPS);
        GAS v2u* o8 = (GAS v2u*)(F.XN + (size_t)row * D) + lane;
#pragma unroll
        for (int j = 0; j < 4; ++j) { const int col = 256 * j + 4 * lane;
            const f32x4 g = *(const GAS f32x4*)(F.g_mix_pre + col), sc = *(const GAS f32x4*)(mod + D + col), sh = *(const GAS f32x4*)(mod + col);
            const f32x4 y = v[j] * r * g * (1.0f + sc) + sh; v2u w; w.x = pk2(y.x, y.y); w.y = pk2(y.z, y.w); o8[64 * j] = w; }
    }
}

constexpr int UX_BYTES = 264 * 128, UXA_OFF = 0, UXB_OFF = UX_BYTES, UG_OFF = 2 * UX_BYTES, WC_OFF = UG_OFF + 256 * 64, WSTR = 144, CST_OFF = WC_OFF + 128 * WSTR, WAGG_OFF = CST_OFF + 12 * 64 * 4, HC_OFF = WAGG_OFF + 8 * 2 * 32 * 8;
static_assert(HC_OFF + 256 <= MISC_OFF, "LRU LDS map");
constexpr size_t WS_ZERO = 512 * KiB;
static_assert(WS_ZERO + 128 <= CTL_ZERO_BYTES && WS_ZERO >= WS_MOD + 5 * NMOD * 4, "zero block inside the memset region");

__device__ __forceinline__ float lane_from(float v, int addr) { return __builtin_bit_cast(float, __builtin_amdgcn_ds_bpermute(addr, __builtin_bit_cast(int, v))); }

__device__ __forceinline__ void lru_dma(Frame& F, const int ci, const int h, const int c32, const int uxoff, const bool with_ux, const bool with_ug, const int w, const int lane) {
    if (w == 0) return;
    LAS unsigned char* lds = F.lds;
    const int row0 = ci * 256; const bool samp = ci >= NCH_P; const int q = samp ? ((ci - NCH_P) & 15) : 0; const bool has_prev = samp && q > 0, has_next = samp && q < 15;
    const bf16* zero = (const bf16*)((const unsigned char*)F.ctl + WS_ZERO);
#pragma unroll
    for (int j = 0; j < 7; ++j) { const int pi = (w - 1) + 7 * j;
        if (pi < 33) { if (with_ux) { const int rr = 8 * pi + (lane >> 3), c = (lane & 7) ^ ((lane >> 3) & 7);
                const bool valid = rr < 259 && (rr >= 2 || has_prev) && (rr < 258 || has_next);
                const bf16* src = valid ? F.U + (size_t)(row0 - 2 + rr) * NIN + PW + h * HD + c * 8 : zero + c * 8;
                __builtin_amdgcn_global_load_lds((const GAS unsigned*)src, (LAS unsigned*)(lds + uxoff + pi * 1024), 16, 0, 0); } }
        else if (with_ug) { const int p = pi - 33, rr = 16 * p + (lane >> 2);
            __builtin_amdgcn_global_load_lds((const GAS unsigned*)(F.U + (size_t)(row0 + rr) * NIN + PW + LW + h * HD + c32 + (lane & 3) * 8), (LAS unsigned*)(lds + UG_OFF + p * 1024), 16, 0, 0); } }
}

__device__ __forceinline__ void lru_setup(Frame& F, const int hh) {
    const int tid = F.tid, h = hh >> 1, c32 = (hh & 1) * 32; LAS unsigned char* lds = F.lds;
#pragma unroll
    for (int it = 0; it < 2; ++it) { const int idx = tid + it * NWAVES * 64, col = idx >> 3, kc = idx & 7, srow = (col >> 5) * 64 + c32 + (col & 31);
        *(LAS v4u*)(lds + WC_OFF + col * WSTR + kc * 16) = *(const GAS v4u*)(F.Wcat + ((size_t)(h * 256 + srow) * 64 + kc * 8)); }
    if (tid < 64) { const int chh = h * HD + tid; LAS float* c = (LAS float*)(lds + CST_OFF) + tid;
        c[0] = F.convw[chh]; c[64] = F.convw[LW + chh]; c[128] = F.convw[2 * LW + chh]; c[192] = F.convw[3 * LW + chh]; c[256] = F.convb[chh];
        const float nl2e = -1.4426950408889634f;
        c[320] = nl2e * F.ba[chh]; c[384] = nl2e * F.ba[LW + chh]; c[448] = nl2e * F.bx[chh]; c[512] = nl2e * F.bx[LW + chh]; c[576] = F.LSC[chh]; c[640] = F.LSC[LW + chh]; c[704] = 0.f; }
}

template <bool FULL>
__device__ __forceinline__ void lru_unit(Frame& F, const int ci, const int hh, const int uxoff, const int nci  , const bool first) {
    int tid = F.tid, w = F.wave; asm volatile("" : "+v"(tid)); asm volatile("" : "+s"(w));
    const int lane = tid & 63, fr = lane & 15, fq = lane >> 4, h = hh >> 1, c32 = (hh & 1) * 32;
    LAS unsigned char* lds = F.lds;
    const int row0 = ci * 256; const bool samp = ci >= NCH_P; const int q = samp ? ((ci - NCH_P) & 15) : 0;
    if (first) asm volatile("s_waitcnt vmcnt(0)" ::: "memory");
    RAW_BARRIER();
    f32x2 tq[16]; float hc0 = 0.f;
    if constexpr (FULL) { if (w == 0 && samp) { const int d = lane >> 5, cl = lane & 31, chh = h * HD + c32 + cl, b = (ci - NCH_P) >> 4;
            hc0 = F.state[(b * 2 + d) * LW + chh]; const f32x2* cg = F.CAGG + ((size_t)(b * 16) * 2 + d) * LW + chh;
#pragma unroll
            for (int qq = 0; qq < 16; ++qq) tq[qq] = cg[(size_t)qq * 2 * LW]; } }
    lru_dma(F, nci >= 0 ? nci : ci, h, c32, uxoff ^ UX_BYTES, nci >= 0, false, w, lane);
    if constexpr (FULL) lru_dma(F, ci, h, c32, 0, false, true, w, lane);
    bf16x8 afr[2][2];
#pragma unroll
    for (int ks = 0; ks < 2; ++ks) { const int c = 4 * ks + fq; float cw[5][8];
#pragma unroll
        for (int p = 0; p < 5; ++p) { const f32x4 lo = *(const LAS f32x4*)(lds + CST_OFF + (p * 64 + c * 8) * 4), hi = *(const LAS f32x4*)(lds + CST_OFF + (p * 64 + c * 8 + 4) * 4);
            cw[p][0] = lo.x; cw[p][1] = lo.y; cw[p][2] = lo.z; cw[p][3] = lo.w; cw[p][4] = hi.x; cw[p][5] = hi.y; cw[p][6] = hi.z; cw[p][7] = hi.w; }
#pragma unroll
        for (int mt = 0; mt < 2; ++mt) { const int T = 32 * w + 16 * mt + fr; float xb[8];
#pragma unroll
            for (int e = 0; e < 8; ++e) xb[e] = cw[4][e];
#pragma unroll
            for (int k = 0; k < 4; ++k) { const int r = T + k; const v4u v = *(const LAS v4u*)(lds + uxoff + r * 128 + ((c ^ (r & 7)) << 4));
                xb[0] += cw[k][0] * bflo(v.x); xb[1] += cw[k][1] * bfhi(v.x); xb[2] += cw[k][2] * bflo(v.y); xb[3] += cw[k][3] * bfhi(v.y);
                xb[4] += cw[k][4] * bflo(v.z); xb[5] += cw[k][5] * bfhi(v.z); xb[6] += cw[k][6] * bflo(v.w); xb[7] += cw[k][7] * bfhi(v.w); }
            v4u o; o.x = pk2(xb[0], xb[1]); o.y = pk2(xb[2], xb[3]); o.z = pk2(xb[4], xb[5]); o.w = pk2(xb[6], xb[7]);
            afr[mt][ks] = __builtin_bit_cast(bf16x8, o); } }
    f32x4 acc[2][8];
#pragma unroll
    for (int mt = 0; mt < 2; ++mt)
#pragma unroll
        for (int nt = 0; nt < 8; ++nt) acc[mt][nt] = (f32x4){0.f, 0.f, 0.f, 0.f};
#pragma unroll
    for (int nt = 0; nt < 8; ++nt)
#pragma unroll
        for (int ks = 0; ks < 2; ++ks) { const bf16x8 b = *(const LAS bf16x8*)(lds + WC_OFF + (16 * nt + fr) * WSTR + (32 * ks + 8 * fq) * 2);
#pragma unroll
            for (int mt = 0; mt < 2; ++mt) acc[mt][nt] = __builtin_amdgcn_mfma_f32_16x16x32_bf16(afr[mt][ks], b, acc[mt][nt], 0, 0, 0); }
#pragma unroll
    for (int cq = 0; cq < 2; ++cq) { const int ch = c32 + 16 * cq + fr, cc = ch >> 3, ce = (ch & 7) * 2; const LAS float* c = (const LAS float*)(lds + CST_OFF) + ch;
#pragma unroll
        for (int mt = 0; mt < 2; ++mt) { float ux[7], xbf[4];
#pragma unroll
            for (int r7 = 0; r7 < 7; ++r7) { const int r = 32 * w + 16 * mt + 4 * fq + r7;
                ux[r7] = __builtin_bit_cast(float, (unsigned)(*(const LAS unsigned short*)(lds + uxoff + r * 128 + ((cc ^ (r & 7)) << 4) + ce)) << 16); }
            { const float cw0 = c[0], cw1 = c[64], cw2 = c[128], cw3 = c[192], cbv = c[256];
#pragma unroll
              for (int i = 0; i < 4; ++i) xbf[i] = cbv + cw0 * ux[i] + cw1 * ux[i + 1] + cw2 * ux[i + 2] + cw3 * ux[i + 3]; }
#pragma unroll
            for (int d = 0; d < 2; ++d) { const float bA = c[320 + 64 * d], bX = c[448 + 64 * d], c8 = c[576 + 64 * d];
#pragma unroll
                for (int i = 0; i < 4; ++i) { const float r = __builtin_amdgcn_rcpf(1.0f + __builtin_amdgcn_exp2f(acc[mt][4 * d + cq][i] + bA)), ig = __builtin_amdgcn_rcpf(1.0f + __builtin_amdgcn_exp2f(acc[mt][4 * d + 2 + cq][i] + bX));
                    const float a = __builtin_amdgcn_exp2f(r * c8), mult = __builtin_amdgcn_sqrtf(1.0f - a * a);
                    acc[mt][4 * d + cq][i] = a; acc[mt][4 * d + 2 + cq][i] = mult * (ig * xbf[i]); } } } }
    float ea[2][2][2], eb[2][2][2];
    { const int ad1[2] = {((lane - 16) & 63) << 2, ((lane + 16) & 63) << 2}, ad2[2] = {((lane - 32) & 63) << 2, ((lane + 32) & 63) << 2}, adl[2] = {(fr + 48) << 2, fr << 2};
#pragma unroll
      for (int d = 0; d < 2; ++d) { const bool ok1 = d == 0 ? fq >= 1 : fq <= 2, ok2 = d == 0 ? fq >= 2 : fq <= 1;
#pragma unroll
        for (int cq = 0; cq < 2; ++cq) { float IA[2], IB[2], TA[2], TB[2], XA[2], XB[2];
#pragma unroll
            for (int mt = 0; mt < 2; ++mt) { const f32x4 a = acc[mt][4 * d + cq], b = acc[mt][4 * d + 2 + cq];
                float A = (a[0] * a[1]) * (a[2] * a[3]);
                float B = d == 0 ? ((b[0] * a[1] + b[1]) * a[2] + b[2]) * a[3] + b[3] : ((b[3] * a[2] + b[2]) * a[1] + b[1]) * a[0] + b[0];
                { const float pa = lane_from(A, ad1[d]), pb = lane_from(B, ad1[d]); if (ok1) { B = A * pb + B; A = A * pa; } }
                { const float pa = lane_from(A, ad2[d]), pb = lane_from(B, ad2[d]); if (ok2) { B = A * pb + B; A = A * pa; } }
                IA[mt] = A; IB[mt] = B;
                XA[mt] = lane_from(A, ad1[d]); XB[mt] = lane_from(B, ad1[d]); if (!ok1) { XA[mt] = 1.f; XB[mt] = 0.f; }
                TA[mt] = lane_from(A, adl[d]); TB[mt] = lane_from(B, adl[d]); }
            const int m1 = d == 0 ? 0 : 1, m2 = 1 - m1;
            ea[d][cq][m1] = XA[m1]; eb[d][cq][m1] = XB[m1];
            ea[d][cq][m2] = XA[m2] * TA[m1]; eb[d][cq][m2] = XA[m2] * TB[m1] + XB[m2];
            if (fq == 0) *(LAS f32x2*)(lds + WAGG_OFF + ((w * 2 + d) * 32 + 16 * cq + fr) * 8) = (f32x2){TA[m2] * TA[m1], TA[m2] * TB[m1] + TB[m2]}; } } }
    if (w == 0) { const int d = lane >> 5; float hc = hc0;
        if constexpr (FULL) { if (samp) {
                if (d == 0) {
#pragma unroll
                    for (int qq = 0; qq < 16; ++qq) if (qq < q) hc = tq[qq].x * hc + tq[qq].y; }
                else {
#pragma unroll
                    for (int qq = 15; qq >= 0; --qq) if (qq > q) hc = tq[qq].x * hc + tq[qq].y; } } }
        *(LAS float*)(lds + HC_OFF + lane * 4) = hc; }
    asm volatile("s_waitcnt vmcnt(0)" ::: "memory");
    RAW_BARRIER();
    if (w == 0) { const int d = lane >> 5, cl = lane & 31, chh = h * HD + c32 + cl;
        f32x2 wg[8];
#pragma unroll
        for (int ww = 0; ww < 8; ++ww) wg[ww] = *(const LAS f32x2*)(lds + WAGG_OFF + ((ww * 2 + d) * 32 + cl) * 8);
        if constexpr (FULL) { if (!samp) { float hc = 0.f;
#pragma unroll
                for (int s = 0; s < 8; ++s) { const f32x2 t = d == 0 ? wg[s] : wg[7 - s]; hc = t.x * hc + t.y; }
                F.newstate[(ci * 2 + d) * LW + chh] = hc; } }
        else { float P = 1.f, Bc = 0.f;
#pragma unroll
            for (int s = 0; s < 8; ++s) { const f32x2 t = d == 0 ? wg[s] : wg[7 - s]; Bc = t.x * Bc + t.y; P *= t.x; }
            F.CAGG[((size_t)(ci - NCH_P) * 2 + d) * LW + chh] = (f32x2){P, Bc}; } }
    if constexpr (FULL) {
#pragma unroll
        for (int cq = 0; cq < 2; ++cq) { const int cl = 16 * cq + fr;
            float hw[2];
#pragma unroll
            for (int d = 0; d < 2; ++d) { float hc = *(const LAS float*)(lds + HC_OFF + (d * 32 + cl) * 4);
#pragma unroll
                for (int s = 0; s < 7; ++s) { const int ww = d == 0 ? s : 7 - s; const f32x2 t = *(const LAS f32x2*)(lds + WAGG_OFF + ((ww * 2 + d) * 32 + cl) * 8);
                    const bool use = d == 0 ? ww < w : ww > w; if (use) hc = t.x * hc + t.y; }
                hw[d] = hc; }
#pragma unroll
            for (int mt = 0; mt < 2; ++mt) { const f32x4 a0 = acc[mt][cq], b0 = acc[mt][2 + cq], a1 = acc[mt][4 + cq], b1 = acc[mt][6 + cq];
                float hf = ea[0][cq][mt] * hw[0] + eb[0][cq][mt], hb = ea[1][cq][mt] * hw[1] + eb[1][cq][mt];
                float y[4];
#pragma unroll
                for (int i = 0; i < 4; ++i) { hf = a0[i] * hf + b0[i]; y[i] = hf; }
#pragma unroll
                for (int i = 3; i >= 0; --i) { hb = a1[i] * hb + b1[i]; y[i] += hb; }
#pragma unroll
                for (int i = 0; i < 4; ++i) { const int t = 32 * w + 16 * mt + 4 * fq + i; LAS unsigned short* p = (LAS unsigned short*)(lds + UG_OFF + t * 64 + cl * 2);
                    const float x = __builtin_bit_cast(float, (unsigned)(*p) << 16);
                    const float ge = x * fsigmoid(1.5957691216057308f * (x + 0.044715f * x * x * x));
                    *p = (unsigned short)pk2(y[i] * ge, 0.f); } } }
        RAW_BARRIER();
#pragma unroll
        for (int it = 0; it < 2; ++it) { const int idx = tid + it * NWAVES * 64, t = idx >> 2, c4 = idx & 3;
            *(GAS v4u*)(F.MIX + (size_t)(row0 + t) * D + PW + h * HD + c32 + c4 * 8) = *(const LAS v4u*)(lds + UG_OFF + t * 64 + c4 * 16); }
    }
}
template <bool FULL>
__device__ __forceinline__ void lru_units(Frame& F, const int ci_base, const int nunits) {
    if (F.vcu >= nunits) return;
    const int hh0 = F.vcu % 16;
    lru_setup(F, hh0);
    lru_dma(F, ci_base + F.vcu / 16, hh0 >> 1, (hh0 & 1) * 32, UXA_OFF, true, false, F.wave, F.lane);
    int buf = 0;
    for (int u = F.vcu; u < nunits; u += F.G, buf ^= 1) { const int un = u + F.G; const int hh = u % 16;
        if (hh != hh0) { __syncthreads(); lru_setup(F, hh); }
        lru_unit<FULL>(F, ci_base + u / 16, hh, buf ? UXB_OFF : UXA_OFF, (un < nunits && (un % 16) == hh) ? ci_base + un / 16 : -1, u == F.vcu); }
    asm volatile("s_waitcnt vmcnt(0)" ::: "memory");
    __syncthreads();
}

constexpr int UP_BYTES = 144 * 256, UP_STRIDE = 256, PM_OFF = 2 * UP_BYTES, PM_STRIDE = 272, WP_OFF = PM_OFF + 128 * PM_STRIDE;
static_assert(WP_OFF + 128 * PM_STRIDE <= MISC_OFF, "pool LDS map");
__device__ __forceinline__ void pool_setup(Frame& F, const int g) {
    const int tid = F.tid; LAS unsigned char* lds = F.lds;
#pragma unroll
    for (int it = 0; it < 4; ++it) { const int idx = tid + it * NWAVES * 64, dcol = idx >> 4, kc = idx & 15;
        *(LAS v4u*)(lds + WP_OFF + dcol * PM_STRIDE + kc * 16) = *(const GAS v4u*)(F.Wpt + ((size_t)(g * 128 + dcol) * 128 + kc * 8)); }
}
__device__ __forceinline__ void pool_dma(Frame& F, const int blk, const int g, const int upoff, const int w, const int lane) {
    LAS unsigned char* lds = F.lds; const int row0 = blk * 128; const bf16* zero = (const bf16*)((const unsigned char*)F.ctl + WS_ZERO);
#pragma unroll
    for (int j = 0; j < 5; ++j) { const int pi = w + 8 * j;
        if (pi < 36) { const int grow = row0 - 8 + 4 * pi + (lane >> 4), cg = lane & 15;
            const bf16* src = (grow >= 0 && grow < M) ? F.U + (size_t)grow * NIN + g * 128 + cg * 8 : zero + (cg & 7) * 8;
            __builtin_amdgcn_global_load_lds((const GAS unsigned*)src, (LAS unsigned*)(lds + upoff + pi * 1024), 16, 0, 0); } }
}
template <int G_>
__device__ __forceinline__ void pool_unit(Frame& F, const int blk, const int upoff, const int nblk  ) {
    constexpr int g = G_, WIN = 2 << g, LEFT = WIN / 2, RIGHT = WIN - 1 - LEFT;
    int tid = F.tid, w = F.wave; asm volatile("" : "+v"(tid)); asm volatile("" : "+s"(w));
    const int lane = tid & 63, fr = lane & 15, fq = lane >> 4;
    LAS unsigned char* lds = F.lds;
    const int row0 = blk * 128, segl = row0 < MP ? SEQ : GRIDW;
    asm volatile("s_waitcnt vmcnt(0)" ::: "memory");
    RAW_BARRIER();
    if (nblk >= 0) pool_dma(F, nblk, g, upoff ^ UP_BYTES, w, lane);
#pragma unroll
    for (int it = 0; it < 4; ++it) { const int idx = tid + it * NWAVES * 64, t = idx >> 4, cg = idx & 15, row = row0 + t;
        const int tl = row < MP ? (row & (SEQ - 1)) : ((row - MP) & (GRIDW - 1)), lo = max(tl - LEFT, 0), hi = min(tl + RIGHT + 1, segl);
        float s[8] = {0.f, 0.f, 0.f, 0.f, 0.f, 0.f, 0.f, 0.f};
#pragma unroll
        for (int p = 0; p < WIN; ++p) { const int pos = tl - LEFT + p; const bool ok = pos >= 0 && pos < segl;
            v4u v = *(const LAS v4u*)(lds + upoff + (t + 8 - LEFT + p) * UP_STRIDE + cg * 16); if (!ok) v = (v4u){0u, 0u, 0u, 0u};
            s[0] += bflo(v.x); s[1] += bfhi(v.x); s[2] += bflo(v.y); s[3] += bfhi(v.y); s[4] += bflo(v.z); s[5] += bfhi(v.z); s[6] += bflo(v.w); s[7] += bfhi(v.w); }
        const float inv = 1.0f / (float)(hi - lo);
        const v4u sv = *(const LAS v4u*)(lds + upoff + (t + 8) * UP_STRIDE + cg * 16);
        v4u o; o.x = pk2(s[0] * inv - bflo(sv.x), s[1] * inv - bfhi(sv.x)); o.y = pk2(s[2] * inv - bflo(sv.y), s[3] * inv - bfhi(sv.y));
        o.z = pk2(s[4] * inv - bflo(sv.z), s[5] * inv - bfhi(sv.z)); o.w = pk2(s[6] * inv - bflo(sv.w), s[7] * inv - bfhi(sv.w));
        *(LAS v4u*)(lds + PM_OFF + t * PM_STRIDE + cg * 16) = o; }
    RAW_BARRIER();
    f32x4 acc[8];
#pragma unroll
    for (int nt = 0; nt < 8; ++nt) acc[nt] = (f32x4){0.f, 0.f, 0.f, 0.f};
    { bf16x8 a[4];
#pragma unroll
      for (int ks = 0; ks < 4; ++ks) a[ks] = *(const LAS bf16x8*)(lds + PM_OFF + (16 * w + fr) * PM_STRIDE + (32 * ks + 8 * fq) * 2);
#pragma unroll
      for (int nt = 0; nt < 8; ++nt)
#pragma unroll
          for (int ks = 0; ks < 4; ++ks) acc[nt] = __builtin_amdgcn_mfma_f32_16x16x32_bf16(*(const LAS bf16x8*)(lds + WP_OFF + (16 * nt + fr) * PM_STRIDE + (32 * ks + 8 * fq) * 2), a[ks], acc[nt], 0, 0, 0); }
#pragma unroll
    for (int nt = 0; nt < 8; ++nt) { const int dcol = 16 * nt + 4 * fq; const f32x4 ps = *(const GAS f32x4*)(F.pscale + g * 128 + dcol);
        v2u o; o.x = pk2(acc[nt][0] * ps.x, acc[nt][1] * ps.y); o.y = pk2(acc[nt][2] * ps.z, acc[nt][3] * ps.w);
        *(LAS v2u*)(lds + upoff + (16 * w + fr) * UP_STRIDE + dcol * 2) = o; }
    RAW_BARRIER();
#pragma unroll
    for (int it = 0; it < 4; ++it) { const int idx = tid + it * NWAVES * 64, t = idx >> 4, cg = idx & 15;
        *(GAS v4u*)(F.MIX + (size_t)(row0 + t) * D + g * 128 + cg * 8) = *(const LAS v4u*)(lds + upoff + t * UP_STRIDE + cg * 16); }
}
__device__ __forceinline__ void pool_units(Frame& F, const int ubase, const int nunits) {
    int u = F.vcu; while (u < ubase) u += F.G;
    if (u >= ubase + nunits) return;
    const int g0 = (u - ubase) & 3;
    pool_setup(F, g0);
    pool_dma(F, (u - ubase) >> 2, g0, 0, F.wave, F.lane);
    int buf = 0;
    for (; u < ubase + nunits; u += F.G, buf ^= 1) { const int v = u - ubase, g = v & 3, un = u + F.G; const bool has_next = un < ubase + nunits && ((un - ubase) & 3) == g;
        if (g != g0) break;
        const int nb = has_next ? (un - ubase) >> 2 : -1, up = buf ? UP_BYTES : 0;
        switch (g) { case 0: pool_unit<0>(F, v >> 2, up, nb); break; case 1: pool_unit<1>(F, v >> 2, up, nb); break; case 2: pool_unit<2>(F, v >> 2, up, nb); break; default: pool_unit<3>(F, v >> 2, up, nb); break; } }
    asm volatile("s_waitcnt vmcnt(0)" ::: "memory");
    __syncthreads();
}

__device__ __forceinline__ void p6_rows(Frame& F) {
    const int gw = F.vcu * NWAVES + F.wave, NGW = F.G * NWAVES, lane = F.lane;
    for (int row = gw; row < M; row += NGW) {
        const GAS f32x4* xr = (const GAS f32x4*)xrow(F, row) + lane; const GAS v2u* mr = (const GAS v2u*)(F.MIXO + (size_t)row * D) + lane; const float* mod = F.MOD + mod_idx(row) * NMOD;
        f32x4 v[4], x[4]; float s = 0.f;
#pragma unroll
        for (int j = 0; j < 4; ++j) { const v2u mw = mr[64 * j]; v[j] = (f32x4){bflo(mw.x), bfhi(mw.x), bflo(mw.y), bfhi(mw.y)}; x[j] = xr[64 * j]; s += (v[j].x * v[j].x + v[j].y * v[j].y) + (v[j].z * v[j].z + v[j].w * v[j].w); }
        const float r = rsqrtf(wave_sum(s) * (1.f / D) + EPS); float s2 = 0.f;
#pragma unroll
        for (int j = 0; j < 4; ++j) { const int col = 256 * j + 4 * lane;
            const f32x4 gp = *(const GAS f32x4*)(F.g_mix_post + col), g1 = *(const GAS f32x4*)(mod + 2 * D + col);
            x[j] = x[j] + g1 * (v[j] * r * gp); s2 += (x[j].x * x[j].x + x[j].y * x[j].y) + (x[j].z * x[j].z + x[j].w * x[j].w); }
        const float r2 = rsqrtf(wave_sum(s2) * (1.f / D) + EPS);
        GAS f32x4* o = (GAS f32x4*)(F.out + (size_t)row * D) + lane; GAS v2u* o8 = (GAS v2u*)(F.H2 + (size_t)row * D) + lane;
#pragma unroll
        for (int j = 0; j < 4; ++j) { const int col = 256 * j + 4 * lane; o[64 * j] = x[j];
            const f32x4 g = *(const GAS f32x4*)(F.g_ffn_pre + col), sc = *(const GAS f32x4*)(mod + 4 * D + col), sh = *(const GAS f32x4*)(mod + 3 * D + col);
            const f32x4 y = x[j] * r2 * g * (1.0f + sc) + sh; v2u wv; wv.x = pk2(y.x, y.y); wv.y = pk2(y.z, y.w); o8[64 * j] = wv; }
    }
}
__device__ __forceinline__ void p9_rows(Frame& F) {
    const int gw = F.vcu * NWAVES + F.wave, NGW = F.G * NWAVES, lane = F.lane;
    for (int row = gw; row < M; row += NGW) {
        GAS f32x4* o = (GAS f32x4*)(F.out + (size_t)row * D) + lane; const GAS v2u* fr_ = (const GAS v2u*)(F.FF + (size_t)row * D) + lane; const float* mod = F.MOD + mod_idx(row) * NMOD;
        f32x4 v[4], x[4]; float s = 0.f;
#pragma unroll
        for (int j = 0; j < 4; ++j) { const v2u fw = fr_[64 * j]; v[j] = (f32x4){bflo(fw.x), bfhi(fw.x), bflo(fw.y), bfhi(fw.y)}; x[j] = o[64 * j]; s += (v[j].x * v[j].x + v[j].y * v[j].y) + (v[j].z * v[j].z + v[j].w * v[j].w); }
        const float r = rsqrtf(wave_sum(s) * (1.f / D) + EPS);
#pragma unroll
        for (int j = 0; j < 4; ++j) { const int col = 256 * j + 4 * lane;
            const f32x4 gp = *(const GAS f32x4*)(F.g_ffn_post + col), g2 = *(const GAS f32x4*)(mod + 5 * D + col);
            o[64 * j] = x[j] + g2 * (v[j] * r * gp); }
    }
}

struct Args { const float* in[24]; float* out; unsigned char* ws; int ph_lo, ph_hi; };
static_assert(sizeof(Args) == 26 * 8 + 8, "Args has no padding");
__global__ void __launch_bounds__(NWAVES * 64, 2) mega_fwd(Args args) {
    extern __shared__ __attribute__((aligned(16))) unsigned char lds[];
    Frame F;
    F.lds = (LAS unsigned char*)lds;
    F.MISC = (volatile LAS unsigned*)(F.lds + MISC_OFF);
    F.tid = threadIdx.x; F.lane = F.tid & 63; F.wave = __builtin_amdgcn_readfirstlane(F.tid >> 6);
    F.G = gridDim.x; { const int bx = blockIdx.x; F.vcu = (F.G % 8 == 0) ? (bx % 8) * (F.G / 8) + bx / 8 : bx; }
    unsigned char* ws = args.ws;
    F.ctl = (gu32*)(ws + WS_CTL);
    F.xp = args.in[0]; F.xs = args.in[1]; F.c = args.in[2]; F.state = args.in[3]; F.cctx = args.in[4]; F.wmod = args.in[5]; F.bmod = args.in[6];
    F.g_mix_pre = args.in[7]; F.g_mix_post = args.in[8]; F.g_ffn_pre = args.in[9]; F.g_ffn_post = args.in[10]; F.w_in = args.in[11]; F.w_pool = args.in[12]; F.pscale = args.in[13];
    F.convw = args.in[14]; F.convb = args.in[15]; F.wa = args.in[16]; F.ba = args.in[17]; F.wx = args.in[18]; F.bx = args.in[19]; F.lam = args.in[20];
    F.w_out = args.in[21]; F.w_fi = args.in[22]; F.w_fo = args.in[23];
    F.out = args.out; F.newstate = args.out + (size_t)M * D;
    F.MOD = (float*)(ws + WS_MOD);
    F.Win_t = (bf16*)(ws + WS_WIN); F.Wout_t = (bf16*)(ws + WS_WOUT); F.Wfi_t = (bf16*)(ws + WS_WFI); F.Wfo_t = (bf16*)(ws + WS_WFO); F.Wcat = (bf16*)(ws + WS_WCAT); F.Wpt = (bf16*)(ws + WS_WPT);
    F.LSC = (float*)(ws + WS_LSC); F.CAGG = (f32x2*)(ws + WS_CAGG);
    F.XN = (bf16*)(ws + WS_XN); F.MIX = (bf16*)(ws + WS_XN); F.H2 = (bf16*)(ws + WS_XN); F.FF = (bf16*)(ws + WS_FF);
    F.U = (bf16*)(ws + WS_U); F.MIXO = (bf16*)(ws + WS_U); F.ACT = (bf16*)(ws + WS_ACT);
    for (int u = F.tid; u < (LDS_BYTES - MISC_OFF) / 4; u += NWAVES * 64) ((LAS unsigned*)(F.lds + MISC_OFF))[u] = 0u;
    __syncthreads();
    const int lo = args.ph_lo, hi = args.ph_hi;
    XcdBarrier bar; bar.bar = (unsigned*)(F.ctl + CW_BAR); bar.x = 0; bar.st = nullptr;
    if (hi - lo > 1) bar = xcd_barrier_post((unsigned*)(F.ctl + CW_BAR), F.MISC + 8);
#ifndef PH_MASK
#define PH_MASK 0x3ff
#endif
#define IN(k) (((PH_MASK >> (k)) & 1) && lo <= (k) && (k) < hi)
#define SEAM(k) do { if (IN(k) && IN((k) + 1)) xcd_barrier(bar); } while (0)
#ifndef PROBE_REPEAT
#define PROBE_REPEAT 0
#endif
#define REPS(k) for (int rep_ = 0; rep_ <= ((PROBE_REPEAT >> (k)) & 1); ++rep_, (rep_ <= ((PROBE_REPEAT >> (k)) & 1) ? xcd_barrier(bar) : (void)0))

    if (IN(0)) REPS(0) { p0_prologue(F); } SEAM(0);
    if (IN(1)) REPS(1) { p1_xn(F); } SEAM(1);
    if (IN(2)) REPS(2) {
        pg8::Gemm g{F.XN, F.Win_t, M, NIN, D}; pg8::StaticOrder S; S.init(M, NIN, F.G, (int)blockIdx.x);
        pg8::EpiBf16<0> E{F.U, NIN, nullptr, 0, 0, 1.f};
        pg8::gemm_phase<pg8::EpiBf16<0>, pg8::StaticOrder, true, true>(F.lds + RING_OFF, g, S, E);
    } SEAM(2);
    if (IN(3)) REPS(3) {
        lru_units<false>(F, NCH_P, NCH_S * 2 * NHEAD);
        pool_units(F, NCH_S * 2 * NHEAD, (M / 128) * 4);
    } SEAM(3);
    if (IN(4)) REPS(4) {
        lru_units<true>(F, 0, NCH * 2 * NHEAD);
    } SEAM(4);
    if (IN(5)) REPS(5) {
        pg8::Gemm g{F.MIX, F.Wout_t, M, D, D}; pg8::StaticOrder S; S.init(M, D, F.G, (int)blockIdx.x);
        pg8::EpiBf16<0> E{F.MIXO, D, nullptr, 0, 0, 1.f};
        pg8::gemm_phase<pg8::EpiBf16<0>, pg8::StaticOrder, true, true>(F.lds + RING_OFF, g, S, E);
    } SEAM(5);
    if (IN(6)) REPS(6) { p6_rows(F); } SEAM(6);
    if (IN(7)) REPS(7) {
        pg8::Gemm g{F.H2, F.Wfi_t, M, 2 * DFF, D}; pg8::StaticOrder S; S.init(M, 2 * DFF, F.G, (int)blockIdx.x);
        pg8::EpiSwiglu E{F.ACT, DFF};
        pg8::gemm_phase<pg8::EpiSwiglu, pg8::StaticOrder, true, true>(F.lds + RING_OFF, g, S, E);
    } SEAM(7);
    if (IN(8)) REPS(8) {
        pg8::Gemm g{F.ACT, F.Wfo_t, M, D, DFF}; pg8::StaticOrder S; S.init(M, D, F.G, (int)blockIdx.x);
        pg8::EpiBf16<0> E{F.FF, D, nullptr, 0, 0, 1.f};
        pg8::gemm_phase<pg8::EpiBf16<0>, pg8::StaticOrder, true, true>(F.lds + RING_OFF, g, S, E);
    } SEAM(8);
    if (IN(9)) REPS(9) { p9_rows(F); }
#ifdef PROBE_TAIL
    xcd_barrier(bar);
    if (PROBE_TAIL & 4) { pg8::Gemm g{F.XN, F.Win_t, M, NIN, D}; pg8::StaticOrder S; S.init(M, NIN, F.G, (int)blockIdx.x); pg8::EpiBf16<0> E{F.U, NIN, nullptr, 0, 0, 1.f};
        pg8::gemm_phase<pg8::EpiBf16<0>, pg8::StaticOrder, true, true>(F.lds + RING_OFF, g, S, E); xcd_barrier(bar); }
    if (PROBE_TAIL & 0x80) { pg8::Gemm g{F.H2, F.Wfi_t, M, 2 * DFF, D}; pg8::StaticOrder S; S.init(M, 2 * DFF, F.G, (int)blockIdx.x); pg8::EpiSwiglu E{F.ACT, DFF};
        pg8::gemm_phase<pg8::EpiSwiglu, pg8::StaticOrder, true, true>(F.lds + RING_OFF, g, S, E); xcd_barrier(bar); }
    if (PROBE_TAIL & 0x100) { pg8::Gemm g{F.ACT, F.Wfo_t, M, D, DFF}; pg8::StaticOrder S; S.init(M, D, F.G, (int)blockIdx.x); pg8::EpiBf16<0> E{F.FF, D, nullptr, 0, 0, 1.f};
        pg8::gemm_phase<pg8::EpiBf16<0>, pg8::StaticOrder, true, true>(F.lds + RING_OFF, g, S, E); xcd_barrier(bar); }
#endif
#undef IN
#undef SEAM
}

extern "C" void kernel_launch(void* const* d_in, const int* in_sizes, int n_in, void* d_out, int out_size, void* d_ws, size_t ws_size, hipStream_t stream) {
    static int grid = 0;
    if (grid == 0) {
        if (n_in != 24 || in_sizes[0] != MP * D || in_sizes[1] != MS * D || out_size != M * D + NB * 2 * LW || ws_size < WS_END) {
            fprintf(stderr, "kernel_launch: unexpected shapes: n_in %d, in0 %d, in1 %d, out %d, ws %zu; nothing launched\n", n_in, n_in > 0 ? in_sizes[0] : -1, n_in > 1 ? in_sizes[1] : -1, out_size, ws_size); grid = -1; return; }
        int dev = 0, cus = 0, per_cu = 0;
        if (hipGetDevice(&dev) != hipSuccess || hipDeviceGetAttribute(&cus, hipDeviceAttributeMultiprocessorCount, dev) != hipSuccess) { fprintf(stderr, "kernel_launch: device query failed\n"); grid = -1; return; }
        if (hipFuncSetAttribute((const void*)mega_fwd, hipFuncAttributeMaxDynamicSharedMemorySize, LDS_BYTES) != hipSuccess) { fprintf(stderr, "kernel_launch: hipFuncSetAttribute failed\n"); grid = -1; return; }
        if (hipOccupancyMaxActiveBlocksPerMultiprocessor(&per_cu, (const void*)mega_fwd, NWAVES * 64, LDS_BYTES) != hipSuccess || per_cu < 1) {
            fprintf(stderr, "kernel_launch: occupancy query reports %d workgroups per CU: the grid cannot be resident; nothing launched\n", per_cu); (void)hipGetLastError(); grid = -1; return; }
        grid = cus;
    }
    if (grid < 0) return;
    if (hipMemsetAsync((char*)d_ws + WS_CTL, 0, CTL_ZERO_BYTES, stream) != hipSuccess) { fprintf(stderr, "kernel_launch: hipMemsetAsync failed\n"); return; }
    Args a{};
    for (int i = 0; i < 24; ++i) a.in[i] = (const float*)d_in[i];
    a.out = (float*)d_out; a.ws = (unsigned char*)d_ws;
#if MK_ONE_LAUNCH
    a.ph_lo = 0; a.ph_hi = N_PHASES;
    hipLaunchKernelGGL(mega_fwd, dim3(grid), dim3(NWAVES * 64), LDS_BYTES, stream, a);
#else
    for (int p = 0; p < N_PHASES; ++p) { a.ph_lo = p; a.ph_hi = p + 1; hipLaunchKernelGGL(mega_fwd, dim3(grid), dim3(NWAVES * 64), LDS_BYTES, stream, a); }
#endif
    const hipError_t le = hipPeekAtLastError();
    if (le != hipSuccess) fprintf(stderr, "kernel_launch: launch failed: %s (grid %d x %d threads, %d B LDS)\n", hipGetErrorName(le), grid, NWAVES * 64, LDS_BYTES);
}
```

```cpp
#include <hip/hip_runtime.h>
#include <cstdio>
#include <cstdint>
namespace pg8 {
#define PG8_LAS __attribute__((address_space(3)))
typedef unsigned short bf16_t;
typedef short bf16x8 __attribute__((ext_vector_type(8)));
typedef float f32x4 __attribute__((ext_vector_type(4)));
typedef unsigned u32x4 __attribute__((ext_vector_type(4)));
constexpr int BM = 256, BK = 64, HALF = 128, HTB = HALF * BK * 2  , STAGE_BYTES = 8 * HTB, NXCD = 8, WGM = 8;
#ifndef PG8_MA
#define PG8_MA 3
#endif
constexpr int MA = PG8_MA, HALF_A = 32 * MA, BMR = 2 * HALF_A;

__host__ __device__ __forceinline__ int lds_byte(int r, int c) { const int st = (r >> 4) * 2 + (c >> 5), rr = r & 15, cc = c & 31, ob = rr * 64 + cc * 2; return st * 1024 + (ob ^ (((ob >> 9) & 1) << 5)); }
__host__ __device__ __forceinline__ void stage_rc(int b, int& R, int& C) { const int st = b / 1024, sb = b % 1024, swz = sb ^ (((sb >> 9) & 1) << 5); R = (st >> 1) * 16 + swz / 64; C = (st & 1) * 32 + (swz % 64) / 2; }
__host__ __device__ __forceinline__ int perm32(int rho) { const int n = rho >> 4, i = rho & 15; return 8 * (i >> 2) + 4 * n + (i & 3); }

struct Unit { int pm, pn; };
struct Gemm { const bf16_t* A; const bf16_t* Bt; int M, N, K; };

struct StaticOrder {
    int nM, nN, nwg, G, c;
    __host__ __device__ void init(int M, int N, int G_, int c_) { nM = M / BMR; nN = N / BM; nwg = nM * nN; G = G_; c = c_; }
    __host__ __device__ bool next(int i, Unit& u) const {
        const long L = (long)i * G + c; if (L >= nwg) return false;
        int wgid = (int)L; { const int q = nwg / NXCD, r = nwg % NXCD, xcd = wgid % NXCD, off = wgid / NXCD; wgid = (xcd < r ? xcd * (q + 1) : r * (q + 1) + (xcd - r) * q) + off; }
        const int nig = WGM * nN, gid = wgid / nig, fm = gid * WGM, gsz = (nM - fm) < WGM ? (nM - fm) : WGM;
        u.pm = fm + ((wgid % nig) % gsz); u.pn = (wgid % nig) / gsz; return true;
    }
    __device__ __forceinline__ void a_ready(const Unit&) const {}
    __device__ __forceinline__ void done(const Unit&) const {}
};

__device__ __forceinline__ unsigned cvt_pk_bf16(float lo, float hi) { unsigned r; asm volatile("v_cvt_pk_bf16_f32 %0, %1, %2" : "=v"(r) : "v"(lo), "v"(hi)); return r; }
typedef float f32x2 __attribute__((ext_vector_type(2)));
__device__ __forceinline__ f32x2 gelu_pk(f32x2 v) {
    const f32x2 av = __builtin_elementwise_abs(v), d = av * 0.2316418882f + 1.0f;
    f32x2 t; t.x = __builtin_amdgcn_rcpf(d.x); t.y = __builtin_amdgcn_rcpf(d.y);
    f32x2 q = t * 0.5307027145f + (-0.7265760135f); q = q * t + 0.7107068705f; q = q * t + (-0.142248368f); q = q * t + 0.127414796f; q = q * t;
    const f32x2 s = (v * v) * (-0.72134752044f);
    f32x2 e; e.x = __builtin_amdgcn_exp2f(s.x); e.y = __builtin_amdgcn_exp2f(s.y);
    const f32x2 m = v * (q * e), r = v - m;
    f32x2 o; o.x = v.x < 0.f ? m.x : r.x; o.y = v.y < 0.f ? m.y : r.y; return o;
}

template <int ACT  > struct EpiBf16 {
    static constexpr bool PERM = true, AFTER_DRAIN = false; static_assert(ACT == 0, "EpiBf16: no activation in this kernel");
    bf16_t* O; int ldc; unsigned obytes;
    __device__ __forceinline__ void operator()(const f32x4 (&acc)[2][2][MA][2], const Unit& u, int wr, int wc, int fr, int fq) const {
        const __amdgpu_buffer_rsrc_t rs = __builtin_amdgcn_make_buffer_rsrc((void*)O, 0, obytes, 0x00020000);
        const int row0 = u.pm * BMR + wr * (HALF_A / 2) + fr, col0 = u.pn * BM + wc * 32 + 8 * fq;
#pragma unroll
        for (int ai = 0; ai < 2; ++ai)
#pragma unroll
            for (int m = 0; m < MA; ++m) { const int eoff = (row0 + ai * HALF_A + m * 16) * ldc + col0;
#pragma unroll
                for (int bj = 0; bj < 2; ++bj) { const f32x4 v0 = acc[ai][bj][m][0], v1 = acc[ai][bj][m][1];
                    u32x4 w; w.x = cvt_pk_bf16(v0[0], v0[1]); w.y = cvt_pk_bf16(v0[2], v0[3]); w.z = cvt_pk_bf16(v1[0], v1[1]); w.w = cvt_pk_bf16(v1[2], v1[3]);
                    __builtin_amdgcn_raw_buffer_store_b128(w, rs, (eoff + bj * HALF) * 2, 0, 16); } }
    }
};
struct EpiF32 {
    static constexpr bool PERM = false, AFTER_DRAIN = false;
    float* C; int ldc;
    __device__ __forceinline__ void operator()(const f32x4 (&acc)[2][2][MA][2], const Unit& u, int wr, int wc, int fr, int fq) const {
        const int row0 = u.pm * BMR + wr * (HALF_A / 2) + fr, col0 = u.pn * BM + wc * 32 + 4 * fq;
#pragma unroll
        for (int ai = 0; ai < 2; ++ai)
#pragma unroll
            for (int m = 0; m < MA; ++m) { float* rowp = C + (size_t)(row0 + ai * HALF_A + m * 16) * ldc + col0;
#pragma unroll
                for (int bj = 0; bj < 2; ++bj)
#pragma unroll
                    for (int n = 0; n < 2; ++n) *(f32x4*)(rowp + bj * HALF + n * 16) = acc[ai][bj][m][n]; }
    }
};
struct EpiSwiglu {
    static constexpr bool PERM = true, AFTER_DRAIN = false;
    bf16_t* O; int ldc; unsigned obytes;
    __device__ __forceinline__ void operator()(const f32x4 (&acc)[2][2][MA][2], const Unit& u, int wr, int wc, int fr, int fq) const {
        const __amdgpu_buffer_rsrc_t rs = __builtin_amdgcn_make_buffer_rsrc((void*)O, 0, obytes, 0x00020000);
        const int row0 = u.pm * BMR + wr * (HALF_A / 2) + fr, col0 = u.pn * HALF + wc * 32 + 8 * fq;
#pragma unroll
        for (int ai = 0; ai < 2; ++ai)
#pragma unroll
            for (int m = 0; m < MA; ++m) { const int eoff = (row0 + ai * HALF_A + m * 16) * ldc + col0;
                float o[8];
#pragma unroll
                for (int n = 0; n < 2; ++n)
#pragma unroll
                    for (int e = 0; e < 4; ++e) { const float g = acc[ai][0][m][n][e], up = acc[ai][1][m][n][e];
                        o[4 * n + e] = g * __builtin_amdgcn_rcpf(1.0f + __builtin_amdgcn_exp2f(-1.4426950408889634f * g)) * up; }
                u32x4 w; w.x = cvt_pk_bf16(o[0], o[1]); w.y = cvt_pk_bf16(o[2], o[3]); w.z = cvt_pk_bf16(o[4], o[5]); w.w = cvt_pk_bf16(o[6], o[7]);
                __builtin_amdgcn_raw_buffer_store_b128(w, rs, eoff * 2, 0, 16); }
    }
};

template <class Epi, class Sched, bool ALIGN_EPI = false, bool SP2 = false>
__device__ __forceinline__ void gemm_phase(PG8_LAS unsigned char* lds, const Gemm g, const Sched& S, const Epi& E) {
    const int tid = threadIdx.x, wid = __builtin_amdgcn_readfirstlane(tid >> 6), lane = tid & 63, wr = wid >> 2, wc = wid & 3, fr = lane & 15, fq = lane >> 4;
    const int K = g.K, nt = K / BK;
    unsigned voffA[2], voffB[2];
#pragma unroll
    for (int i = 0; i < 2; ++i) { int R, C; stage_rc(tid * 16 + i * 8192, R, C); const int Rb = Epi::PERM ? ((R & ~31) + perm32(R & 31)) : R;
        const int Ra = R < HALF_A ? R : R - 32;
        voffA[i] = (unsigned)(Ra * K + C) * 2u; voffB[i] = (unsigned)(Rb * K + C) * 2u; }
    const size_t kstep = (size_t)(BK * 2);
    const size_t hstepA = (size_t)HALF_A * K * 2, hstepB = (size_t)HALF * K * 2;
    const size_t tstepA = 2 * hstepA, tstepB = 2 * hstepB;
    const unsigned ldsw = (unsigned)wid * 1024u;
    const int aoff = lds_byte(wr * (HALF_A / 2) + fr, fq * 8), boff = lds_byte(wc * 32 + fr, fq * 8);
#define PG8_SA(b, h) (((b) * 2 + (h)) * HTB)
#define PG8_SB(b, h) ((4 + (b) * 2 + (h)) * HTB)
#define PG8_STAGE(bufoff, gbase, voff) do { _Pragma("unroll") for (int _i = 0; _i < 2; ++_i) \
        __builtin_amdgcn_global_load_lds((const unsigned*)((const char*)(gbase) + (voff)[_i]), (PG8_LAS unsigned*)(lds + (bufoff) + ldsw + _i * 8192), 16, 0, 0); } while (0)
#define PG8_LDA(dst, b, h) do { _Pragma("unroll") for (int m = 0; m < MA; ++m) _Pragma("unroll") for (int k = 0; k < 2; ++k) dst[m][k] = *(const PG8_LAS bf16x8*)(lds + PG8_SA(b, h) + aoff + m * 2048 + k * 1024); } while (0)
#define PG8_LDB(dst, b, h) do { _Pragma("unroll") for (int n = 0; n < 2; ++n) _Pragma("unroll") for (int k = 0; k < 2; ++k) dst[n][k] = *(const PG8_LAS bf16x8*)(lds + PG8_SB(b, h) + boff + n * 2048 + k * 1024); } while (0)
#define PG8_MMA(ai, bj, At, Bt) do { __builtin_amdgcn_s_setprio(1); _Pragma("unroll") for (int m = 0; m < MA; ++m) _Pragma("unroll") for (int n = 0; n < 2; ++n) _Pragma("unroll") for (int k = 0; k < 2; ++k) \
        acc[ai][bj][m][n] = __builtin_amdgcn_mfma_f32_16x16x32_bf16(Bt[n][k], At[m][k], acc[ai][bj][m][n], 0, 0, 0); __builtin_amdgcn_s_setprio(0); } while (0)
#define PG8_WAIT_V(n) asm volatile("s_waitcnt vmcnt(" #n ")" ::: "memory")
#define PG8_WAIT_L(n) asm volatile("s_waitcnt lgkmcnt(" #n ")" ::: "memory")
#define PG8_BAR __builtin_amdgcn_s_barrier()
#define PG8_SCHED __builtin_amdgcn_sched_barrier(0)
    Unit cur, nxt; int ui = 0;
    if (!S.next(0, cur)) return;
    f32x4 acc[2][2][MA][2];
#pragma unroll
    for (int a = 0; a < 2; ++a)
#pragma unroll
        for (int b = 0; b < 2; ++b)
#pragma unroll
            for (int m = 0; m < MA; ++m)
#pragma unroll
                for (int n = 0; n < 2; ++n) acc[a][b][m][n] = (f32x4){0.f, 0.f, 0.f, 0.f};
    bf16x8 At[MA][2], B0[2][2], B1[2][2];
    const char* cA = (const char*)g.A + (size_t)cur.pm * tstepA; const char* cB = (const char*)g.Bt + (size_t)cur.pn * tstepB;
    S.a_ready(cur);
    if constexpr (SP2) {
        PG8_STAGE(PG8_SB(0, 0), cB, voffB); PG8_STAGE(PG8_SB(0, 1), cB + hstepB, voffB); PG8_STAGE(PG8_SA(0, 0), cA, voffA); PG8_STAGE(PG8_SA(0, 1), cA + hstepA, voffA);
        if (wr == 1) PG8_BAR;
        PG8_WAIT_V(2); PG8_BAR;
        PG8_STAGE(PG8_SB(1, 0), cB + kstep, voffB); PG8_STAGE(PG8_SA(1, 0), cA + kstep, voffA); PG8_STAGE(PG8_SB(1, 1), cB + hstepB + kstep, voffB);
        PG8_WAIT_V(6); PG8_BAR;
    } else {
        PG8_STAGE(PG8_SB(0, 0), cB, voffB); PG8_STAGE(PG8_SA(0, 0), cA, voffA); PG8_STAGE(PG8_SB(0, 1), cB + hstepB, voffB); PG8_STAGE(PG8_SA(0, 1), cA + hstepA, voffA);
        if (wr == 1) PG8_BAR;
        PG8_WAIT_V(4); PG8_BAR;
        PG8_STAGE(PG8_SB(1, 0), cB + kstep, voffB); PG8_STAGE(PG8_SA(1, 0), cA + kstep, voffA); PG8_STAGE(PG8_SB(1, 1), cB + hstepB + kstep, voffB);
        PG8_WAIT_V(6); PG8_BAR;
    }
    for (;;) {
        const bool has_next = S.next(ui + 1, nxt);
        const char* nA = has_next ? (const char*)g.A + (size_t)nxt.pm * tstepA : cA; const char* nB = has_next ? (const char*)g.Bt + (size_t)nxt.pn * tstepB : cB;
        for (int t = 0; t < nt; t += 2) {
            const bool last = (t == nt - 2);
            const char* a1 = cA + (size_t)(t + 1) * kstep;
            const char* a2 = last ? nA : cA + (size_t)(t + 2) * kstep; const char* b2 = last ? nB : cB + (size_t)(t + 2) * kstep;
            const char* a3 = a2 + kstep; const char* b3 = b2 + kstep;
            if (last && has_next) S.a_ready(nxt);
            if constexpr (SP2) {
            PG8_LDB(B0, 0, 0); PG8_LDB(B1, 0, 1); PG8_SCHED; PG8_LDA(At, 0, 0); PG8_STAGE(PG8_SA(1, 1), a1 + hstepA, voffA);
            PG8_WAIT_V(8); PG8_WAIT_L(0); PG8_BAR; PG8_MMA(0, 0, At, B0); PG8_MMA(0, 1, At, B1); PG8_BAR; PG8_SCHED;
            PG8_LDA(At, 0, 1); PG8_STAGE(PG8_SB(0, 0), b2, voffB); PG8_STAGE(PG8_SB(0, 1), b2 + hstepB, voffB); PG8_STAGE(PG8_SA(0, 0), a2, voffA);
            PG8_WAIT_V(8); PG8_WAIT_L(0); PG8_BAR; PG8_MMA(1, 0, At, B0); PG8_MMA(1, 1, At, B1); PG8_BAR; PG8_SCHED;
            PG8_LDB(B0, 1, 0); PG8_LDB(B1, 1, 1); PG8_SCHED; PG8_LDA(At, 1, 0); PG8_STAGE(PG8_SA(0, 1), a2 + hstepA, voffA);
            PG8_WAIT_V(8); PG8_WAIT_L(0); PG8_BAR; PG8_MMA(0, 0, At, B0); PG8_MMA(0, 1, At, B1); PG8_BAR; PG8_SCHED;
            PG8_LDA(At, 1, 1); PG8_STAGE(PG8_SB(1, 0), b3, voffB); PG8_STAGE(PG8_SB(1, 1), b3 + hstepB, voffB); PG8_STAGE(PG8_SA(1, 0), a3, voffA);
            PG8_WAIT_V(8); PG8_WAIT_L(0); PG8_BAR; PG8_MMA(1, 0, At, B0); PG8_MMA(1, 1, At, B1); PG8_BAR; PG8_SCHED;
            } else {
            PG8_LDB(B0, 0, 0); PG8_SCHED; PG8_LDA(At, 0, 0); PG8_STAGE(PG8_SA(1, 1), a1 + hstepA, voffA);
            PG8_WAIT_L(8); PG8_BAR; PG8_WAIT_L(0); PG8_MMA(0, 0, At, B0); PG8_BAR; PG8_SCHED;
            PG8_LDB(B1, 0, 1); PG8_STAGE(PG8_SB(0, 0), b2, voffB);
            PG8_BAR; PG8_WAIT_L(0); PG8_MMA(0, 1, At, B1); PG8_BAR;
            PG8_LDA(At, 0, 1); PG8_STAGE(PG8_SA(0, 0), a2, voffA);
            PG8_BAR; PG8_WAIT_L(0); PG8_MMA(1, 0, At, B0); PG8_BAR; PG8_SCHED;
            PG8_STAGE(PG8_SB(0, 1), b2 + hstepB, voffB);
            PG8_WAIT_V(6); PG8_BAR; PG8_MMA(1, 1, At, B1); PG8_BAR;
            PG8_LDB(B0, 1, 0); PG8_SCHED; PG8_LDA(At, 1, 0); PG8_STAGE(PG8_SA(0, 1), a2 + hstepA, voffA);
            PG8_WAIT_L(8); PG8_BAR; PG8_WAIT_L(0); PG8_MMA(0, 0, At, B0); PG8_BAR; PG8_SCHED;
            PG8_LDB(B1, 1, 1); PG8_STAGE(PG8_SB(1, 0), b3, voffB);
            PG8_BAR; PG8_WAIT_L(0); PG8_MMA(0, 1, At, B1); PG8_BAR;
            PG8_LDA(At, 1, 1); PG8_STAGE(PG8_SA(1, 0), a3, voffA);
            PG8_BAR; PG8_WAIT_L(0); PG8_MMA(1, 0, At, B0); PG8_BAR; PG8_SCHED;
            PG8_STAGE(PG8_SB(1, 1), b3 + hstepB, voffB);
            PG8_WAIT_V(6); PG8_BAR; PG8_MMA(1, 1, At, B1); PG8_BAR;
            }
        }
        if constexpr (ALIGN_EPI) { if (wr == 0) PG8_BAR; }
        if constexpr (!Epi::AFTER_DRAIN) { E(acc, cur, wr, wc, fr, fq); S.done(cur); }
        if (!has_next) break;
#pragma unroll
        for (int a = 0; a < 2; ++a)
#pragma unroll
            for (int b = 0; b < 2; ++b)
#pragma unroll
                for (int m = 0; m < MA; ++m)
#pragma unroll
                    for (int n = 0; n < 2; ++n) acc[a][b][m][n] = (f32x4){0.f, 0.f, 0.f, 0.f};
        cur = nxt; cA = nA; cB = nB; ++ui;
        if constexpr (ALIGN_EPI) { if (wr == 1) PG8_BAR; }
    }
    PG8_WAIT_V(0);
    if constexpr (!ALIGN_EPI) { if (wr == 0) PG8_BAR; }
    PG8_BAR;
    if constexpr (Epi::AFTER_DRAIN) { E.fused(acc, cur, wr, wc, fr, fq, lds, wid, lane); S.done(cur); }
#undef PG8_SA
#undef PG8_SB
#undef PG8_STAGE
#undef PG8_LDA
#undef PG8_LDB
#undef PG8_MMA
#undef PG8_WAIT_V
#undef PG8_WAIT_L
#undef PG8_BAR
#undef PG8_SCHED
}
}

constexpr int NWAVES = 8;
#ifndef MK_ONE_LAUNCH
#define MK_ONE_LAUNCH 1
#endif
constexpr int N_PHASES = 10;

constexpr int D = 1024, NB = 32, SEQ = 256, DB = 4, DSEQ = 4096, GRIDW = 64;
constexpr int MP = NB * SEQ, MS = DB * DSEQ, M = MP + MS;
constexpr int NIN = 1536, PW = 512, LW = 512, DFF = 2816, NMOD = 6 * D, NHEAD = 8, HD = 64;
constexpr int NCH = M / 256, NCH_P = MP / 256, NCH_S = MS / 256;
constexpr float EPS = 1e-6f;

constexpr size_t MiB = 1u << 20, KiB = 1u << 10;
constexpr size_t WS_CTL = 0, CTL_ZERO_BYTES = 1 * MiB;
constexpr size_t WS_MOD = 64 * KiB;
constexpr size_t WS_WIN = 1 * MiB, WS_WOUT = 4 * MiB, WS_WFI = 6 * MiB, WS_WFO = 17 * MiB;
constexpr size_t WS_WCAT = 23 * MiB, WS_WPT = WS_WCAT + 256 * KiB, WS_LSC = WS_WPT + 128 * KiB, WS_CAGG = WS_WCAT + 512 * KiB;
constexpr size_t WS_XN = 24 * MiB;
constexpr size_t WS_U = 72 * MiB;
constexpr size_t WS_FF = 72 * MiB;
constexpr size_t WS_ACT = 124 * MiB;
constexpr size_t WS_END = 256 * MiB;
static_assert(WS_WFO + (size_t)D * DFF * 2 <= WS_WCAT && WS_CAGG + (size_t)NCH_S * 2 * LW * 8 <= WS_XN && WS_ACT + (size_t)M * DFF * 2 <= WS_END && WS_MOD + 5 * NMOD * 4 <= CTL_ZERO_BYTES, "d_ws map");
constexpr int CW_BAR = 4096;

constexpr int LDS_BYTES = 147456;
constexpr int MISC_OFF = LDS_BYTES - 256;
constexpr int RING_OFF = 0;

#define GAS __attribute__((address_space(1)))
#define LAS __attribute__((address_space(3)))
typedef unsigned short bf16;
typedef unsigned v4u __attribute__((ext_vector_type(4)));
typedef unsigned v2u __attribute__((ext_vector_type(2)));
typedef float f32x4 __attribute__((ext_vector_type(4)));
typedef float f32x2 __attribute__((ext_vector_type(2)));
typedef short bf16x8 __attribute__((ext_vector_type(8)));
typedef GAS unsigned gu32;
typedef GAS unsigned long long gu64;
#define RLX_AGENT __ATOMIC_RELAXED, __HIP_MEMORY_SCOPE_AGENT
#define LDS_WAIT() asm volatile("s_waitcnt lgkmcnt(0)" ::: "memory")
#define VM_WAIT() asm volatile("s_waitcnt vmcnt(0)" ::: "memory")
__device__ __forceinline__ unsigned f2bf(float f) { unsigned u = __builtin_bit_cast(unsigned, f); return (u + 0x7fffu + ((u >> 16) & 1u)) >> 16; }
__device__ __forceinline__ unsigned pk2(float lo, float hi) { unsigned r; asm("v_cvt_pk_bf16_f32 %0, %1, %2" : "=v"(r) : "v"(lo), "v"(hi)); return r; }
#define MK_RSRC(p, bytes) __builtin_amdgcn_make_buffer_rsrc((void*)(p), 0, (unsigned)(bytes), 0x00020000)
#define ST16_WT(rs, byteoff, v) __builtin_amdgcn_raw_buffer_store_b128((v), (rs), (int)(byteoff), 0, 16)
__device__ __forceinline__ void st8_wt(void* p, v2u v) { __hip_atomic_store((unsigned long long*)p, (unsigned long long)v.x | ((unsigned long long)v.y << 32), __ATOMIC_RELAXED, __HIP_MEMORY_SCOPE_AGENT); }
#define RAW_BARRIER() do { asm volatile("s_waitcnt lgkmcnt(0)" ::: "memory"); __builtin_amdgcn_s_barrier(); asm volatile("" ::: "memory"); } while (0)
__device__ __forceinline__ float bflo(unsigned w) { return __builtin_bit_cast(float, w << 16); }
__device__ __forceinline__ float bfhi(unsigned w) { return __builtin_bit_cast(float, w & 0xffff0000u); }
__device__ __forceinline__ float fsigmoid(float z) { return __builtin_amdgcn_rcpf(1.0f + __builtin_amdgcn_exp2f(-1.4426950408889634f * z)); }

#define XB_TMO      128
#define XB_XCNT(j)  (256  + 64 * (j))
#define XB_XSUB(j)  (1280 + 64 * (j))
#define XB_XGEN(j)  (2304 + 64 * (j))
#define XB_TOP      3328
#define XB_TOPGEN   3392
#define XCD_BAR_WORDS 3456
#define XB_SPIN_CAP (1u << 18)

__device__ __forceinline__ unsigned xb_ld(unsigned* p)              { return __hip_atomic_load(p, __ATOMIC_RELAXED, __HIP_MEMORY_SCOPE_AGENT); }
__device__ __forceinline__ unsigned xb_add(unsigned* p, unsigned v) { return __hip_atomic_fetch_add(p, v, __ATOMIC_RELAXED, __HIP_MEMORY_SCOPE_AGENT); }
__device__ __forceinline__ unsigned xb_xcc_id() { return (unsigned)__builtin_amdgcn_s_getreg((3 << 11) | 20) & 0xFu; }
#define XB_SPIN(cond, bar) do { unsigned _sp = 0; while (cond) { __builtin_amdgcn_s_sleep(1); \
    if ((++_sp & 255u) == 0u) { if (xb_ld(&(bar)[XB_TMO])) break; if (_sp > XB_SPIN_CAP) { atomicAdd(&(bar)[XB_TMO], 1u); break; } } } } while (0)

struct XcdBarrier {
    unsigned* bar; unsigned x;
    volatile LAS unsigned* st;
};

__device__ __forceinline__ XcdBarrier xcd_barrier_post(unsigned* bar, volatile LAS unsigned* st) {
    XcdBarrier b; b.bar = bar; b.x = xb_xcc_id(); b.st = st;
    if (threadIdx.x == 0) (void)xb_add(&bar[XB_XCNT(b.x)], 1u);
    return b;
}
__device__ __forceinline__ void xcd_barrier_complete(unsigned* bar, unsigned x, unsigned& nloc, unsigned& nx) {
    const unsigned G = gridDim.x * gridDim.y * gridDim.z;
    unsigned sum, cnt, mine, sp = 0u;
    for (;;) {
        sum = 0u; cnt = 0u; mine = 0u;
#pragma unroll
        for (unsigned j = 0; j < 16; ++j) { const unsigned c = xb_ld(&bar[XB_XCNT(j)]); sum += c; cnt += (c > 0u) ? 1u : 0u; mine = (j == x) ? c : mine; }
        if (sum == G) break;
        __builtin_amdgcn_s_sleep(1);
        if ((++sp & 255u) == 0u) { if (xb_ld(&bar[XB_TMO])) break; if (sp > XB_SPIN_CAP) { atomicAdd(&bar[XB_TMO], 1u); break; } }
    }
    nloc = mine > 0u ? mine : 1u; nx = cnt > 0u ? cnt : 1u;
}

__device__ __forceinline__ void xcd_barrier(const XcdBarrier& b) {
    asm volatile("s_waitcnt vmcnt(0)" ::: "memory");
    __syncthreads();
    if (threadIdx.x == 0) {
        unsigned* bar = b.bar;
        __builtin_amdgcn_s_waitcnt(0);
        unsigned nloc = b.st[0], nx = b.st[1];
        if (nloc == 0u) { xcd_barrier_complete(bar, b.x, nloc, nx); b.st[0] = nloc; b.st[1] = nx; }
        const unsigned old = xb_add(&bar[XB_XSUB(b.x)], 1u);
        const unsigned gen = old / nloc;
        if (old + 1u == (gen + 1u) * nloc) {
            __builtin_amdgcn_fence(__ATOMIC_RELEASE, "agent");
            asm volatile("s_waitcnt vmcnt(0)" ::: "memory");
            const unsigned og = xb_add(&bar[XB_TOP], 1u);
            const unsigned tg = og / nx;
            if (og + 1u == (tg + 1u) * nx) xb_add(&bar[XB_TOPGEN], 1u);
            else XB_SPIN(xb_ld(&bar[XB_TOPGEN]) == tg, bar);
            __builtin_amdgcn_fence(__ATOMIC_ACQUIRE, "agent");
            xb_add(&bar[XB_XGEN(b.x)], 1u);
            asm volatile("s_waitcnt vmcnt(0)" ::: "memory");
        } else {
            XB_SPIN(xb_ld(&bar[XB_XGEN(b.x)]) == gen, bar);
            __builtin_amdgcn_fence(__ATOMIC_ACQUIRE, "agent");
            asm volatile("s_waitcnt vmcnt(0)" ::: "memory");
        }
    }
    __syncthreads();
}

struct Frame {
    LAS unsigned char* lds;
    volatile LAS unsigned* MISC;
    gu32* ctl;
    int tid, lane, wave;
    int vcu, G;
    const float *xp, *xs, *c, *state, *cctx, *wmod, *bmod, *g_mix_pre, *g_mix_post, *g_ffn_pre, *g_ffn_post, *w_in, *w_pool, *pscale, *convw, *convb, *wa, *ba, *wx, *bx, *lam, *w_out, *w_fi, *w_fo;
    float* out; float* newstate;
    float* MOD;
    bf16 *Win_t, *Wout_t, *Wfi_t, *Wfo_t, *Wcat, *Wpt;
    float* LSC;
    f32x2* CAGG;
    bf16 *XN, *U, *MIX, *H2, *ACT;
    bf16 *MIXO, *FF;
};
__device__ __forceinline__ const float* xrow(const Frame& F, int row) { return row < MP ? F.xp + (size_t)row * D : F.xs + (size_t)(row - MP) * D; }
__device__ __forceinline__ int mod_idx(int row) { return row < MP ? 0 : 1 + (row - MP) / DSEQ; }
__device__ __forceinline__ float wave_sum(float v) {
#pragma unroll
    for (int o = 1; o < 64; o <<= 1) v += __shfl_xor(v, o);
    return v;
}

__device__ __forceinline__ void p0_transpose_item(const float* W, int K, int N, bf16* WT, int k0, int n0, int drow0, LAS float* scr, int lane) {
    const __amdgpu_buffer_rsrc_t wrs = MK_RSRC(WT, (size_t)K * N * 2);
#pragma unroll 8
    for (int i = 0; i < 32; ++i) { const int kk = 2 * i + (lane >> 5); scr[kk * 33 + (lane & 31)] = W[(size_t)(k0 + kk) * N + n0 + (lane & 31)]; }
    LDS_WAIT(); asm volatile("" ::: "memory");
    const int c = lane & 7;
#pragma unroll
    for (int j = 0; j < 4; ++j) { const int n = (lane >> 3) + 8 * j; const LAS float* s = scr + (8 * c) * 33 + n;
        v4u o; o.x = pk2(s[0 * 33], s[1 * 33]); o.y = pk2(s[2 * 33], s[3 * 33]); o.z = pk2(s[4 * 33], s[5 * 33]); o.w = pk2(s[6 * 33], s[7 * 33]);
        ST16_WT(wrs, ((drow0 + n) * K + k0 + 8 * c) * 2, o); }
    LDS_WAIT(); asm volatile("" ::: "memory");
}
__device__ __forceinline__ void p0_prologue(Frame& F) {
    LAS float* scr = (LAS float*)(F.lds + RING_OFF + F.wave * 16384);
    const int gw = F.vcu * NWAVES + F.wave, NGW = F.G * NWAVES, lane = F.lane;
    constexpr int MOD_UNITS = (NMOD / 64) * (D / 64);
    for (int it = gw; it < MOD_UNITS; it += NGW) {
        const int cg = it % (NMOD / 64), ks = it / (NMOD / 64), col = cg * 64 + lane, k0 = ks * 64;
        float sv[5];
#pragma unroll
        for (int v = 0; v < 5; ++v) { const float x = v == 0 ? F.cctx[k0 + lane] : F.c[(v - 1) * D + k0 + lane]; sv[v] = x * fsigmoid(x); }
        float acc[5] = {0.f, 0.f, 0.f, 0.f, 0.f};
#pragma unroll 16
        for (int kk = 0; kk < 64; ++kk) { const float w = F.wmod[(size_t)(k0 + kk) * NMOD + col];
#pragma unroll
            for (int v = 0; v < 5; ++v) acc[v] += __shfl(sv[v], kk) * w; }
        const float bm = ks == 0 ? F.bmod[col] : 0.f;
#pragma unroll
        for (int v = 0; v < 5; ++v) atomicAdd(F.MOD + v * NMOD + col, acc[v] + bm);
    }
    constexpr int I_IN = (D / 64) * (NIN / 32), I_OUT = (D / 64) * (D / 32), I_FI = (D / 64) * (2 * DFF / 32), I_FO = (DFF / 64) * (D / 32);
    constexpr int NITEMS = I_IN + I_OUT + I_FI + I_FO;
    for (int it = gw; it < NITEMS; it += NGW) {
        int r = it;
        if (r < I_IN) { const int nblk = NIN / 32, kb = r / nblk, nb = r % nblk; p0_transpose_item(F.w_in, D, NIN, F.Win_t, 64 * kb, 32 * nb, 32 * nb, scr, lane); continue; } r -= I_IN;
        if (r < I_OUT) { const int nblk = D / 32, kb = r / nblk, nb = r % nblk; p0_transpose_item(F.w_out, D, D, F.Wout_t, 64 * kb, 32 * nb, 32 * nb, scr, lane); continue; } r -= I_OUT;
        if (r < I_FI) { const int nblk = 2 * DFF / 32, kb = r / nblk, nb = r % nblk, n0 = 32 * nb;
            const int up = n0 >= DFF ? 1 : 0, j0 = n0 - up * DFF, drow0 = 256 * (j0 / 128) + 128 * up + (j0 % 128);
            p0_transpose_item(F.w_fi, D, 2 * DFF, F.Wfi_t, 64 * kb, n0, drow0, scr, lane); continue; } r -= I_FI;
        { const int nblk = D / 32, kb = r / nblk, nb = r % nblk; p0_transpose_item(F.w_fo, DFF, D, F.Wfo_t, 64 * kb, 32 * nb, 32 * nb, scr, lane); }
    }
    const int gt = F.vcu * NWAVES * 64 + F.tid, NGT = F.G * NWAVES * 64;
    for (int e = gt; e < NHEAD * 256 * 64; e += NGT) { const int i = e & 63, col = (e >> 6) & 255, h = e >> 14, type = col >> 6, j = col & 63, d = type >> 1;
        const float* src = (type & 1) ? F.wx : F.wa; F.Wcat[e] = (bf16)f2bf(-1.4426950408889634f * src[((size_t)(d * NHEAD + h) * 64 + i) * 64 + j]); }
    for (int e = gt; e < 4 * 128 * 128; e += NGT) { const int c = e & 127, dd = (e >> 7) & 127, g = e >> 14; F.Wpt[e] = (bf16)f2bf(F.w_pool[(size_t)(g * 128 + c) * 128 + dd]); }
    for (int e = gt; e < 2 * LW; e += NGT) F.LSC[e] = -8.0f * 1.4426950408889634f * log1pf(expf(-F.lam[e]));
}

__device__ __forceinline__ void p1_xn(Frame& F) {
    const int gw = F.vcu * NWAVES + F.wave, NGW = F.G * NWAVES, lane = F.lane;
    for (int row = gw; row < M; row += NGW) {
        const GAS f32x4* xr = (const GAS f32x4*)xrow(F, row) + lane; const float* mod = F.MOD + mod_idx(row) * NMOD;
        f32x4 v[4]; float s = 0.f;
#pragma unroll
        for (int j = 0; j < 4; ++j) { v[j] = xr[64 * j]; s += (v[j].x * v[j].x + v[j].y * v[j].y) + (v[j].z * v[j].z + v[j].w * v[j].w); }
        const float r = rsqrtf(wave_sum(s) * (1.f / D) + EPS);
        GAS v2u* o8 = (GAS v2u*)(F.XN + (size_t)row * D) + lane;
#pragma unroll
        for (int j = 0; j < 4; ++j) { const int col = 256 * j + 4 * lane;
            const f32x4 g = *(const GAS f32x4*)(F.g_mix_pre + col), sc = *(const GAS f32x4*)(mod + D + col), sh = *(const GAS f32x4*)(mod + col);
            const f32x4 y = v[j] * r * g * (1.0f + sc) + sh; v2u w; w.x = pk2(y.x, y.y); w.y = pk2(y.z, y.w); st8_wt((void*)(o8 + 64 * j), w); }
    }
}

constexpr int UX_BYTES = 264 * 128, UXA_OFF = 0, UXB_OFF = UX_BYTES, UG_OFF = 2 * UX_BYTES, WC_OFF = UG_OFF + 256 * 64, WSTR = 144, CST_OFF = WC_OFF + 128 * WSTR, WAGG_OFF = CST_OFF + 12 * 64 * 4, HC_OFF = WAGG_OFF + 8 * 2 * 32 * 8;
static_assert(HC_OFF + 256 <= MISC_OFF, "LRU LDS map");
constexpr size_t WS_ZERO = 512 * KiB;
static_assert(WS_ZERO + 128 <= CTL_ZERO_BYTES && WS_ZERO >= WS_MOD + 5 * NMOD * 4, "zero block inside the memset region");

__device__ __forceinline__ float lane_from(float v, int addr) { return __builtin_bit_cast(float, __builtin_amdgcn_ds_bpermute(addr, __builtin_bit_cast(int, v))); }

__device__ __forceinline__ void lru_dma(Frame& F, const int ci, const int h, const int c32, const int uxoff, const bool with_ux, const bool with_ug, const int w, const int lane) {
    if (w == 0) return;
    LAS unsigned char* lds = F.lds;
    const int row0 = ci * 256; const bool samp = ci >= NCH_P; const int q = samp ? ((ci - NCH_P) & 15) : 0; const bool has_prev = samp && q > 0, has_next = samp && q < 15;
    const bf16* zero = (const bf16*)((const unsigned char*)F.ctl + WS_ZERO);
#pragma unroll
    for (int j = 0; j < 7; ++j) { const int pi = (w - 1) + 7 * j;
        if (pi < 33) { if (with_ux) { const int rr = 8 * pi + (lane >> 3), c = (lane & 7) ^ ((lane >> 3) & 7);
                const bool valid = rr < 259 && (rr >= 2 || has_prev) && (rr < 258 || has_next);
                const bf16* src = valid ? F.U + (size_t)(row0 - 2 + rr) * NIN + PW + h * HD + c * 8 : zero + c * 8;
                __builtin_amdgcn_global_load_lds((const GAS unsigned*)src, (LAS unsigned*)(lds + uxoff + pi * 1024), 16, 0, 0); } }
        else if (with_ug) { const int p = pi - 33, rr = 16 * p + (lane >> 2);
            __builtin_amdgcn_global_load_lds((const GAS unsigned*)(F.U + (size_t)(row0 + rr) * NIN + PW + LW + h * HD + c32 + (lane & 3) * 8), (LAS unsigned*)(lds + UG_OFF + p * 1024), 16, 0, 0); } }
}

__device__ __forceinline__ void lru_setup(Frame& F, const int hh) {
    const int tid = F.tid, h = hh >> 1, c32 = (hh & 1) * 32; LAS unsigned char* lds = F.lds;
#pragma unroll
    for (int it = 0; it < 2; ++it) { const int idx = tid + it * NWAVES * 64, col = idx >> 3, kc = idx & 7, srow = (col >> 5) * 64 + c32 + (col & 31);
        *(LAS v4u*)(lds + WC_OFF + col * WSTR + kc * 16) = *(const GAS v4u*)(F.Wcat + ((size_t)(h * 256 + srow) * 64 + kc * 8)); }
    if (tid < 64) { const int chh = h * HD + tid; LAS float* c = (LAS float*)(lds + CST_OFF) + tid;
        c[0] = F.convw[chh]; c[64] = F.convw[LW + chh]; c[128] = F.convw[2 * LW + chh]; c[192] = F.convw[3 * LW + chh]; c[256] = F.convb[chh];
        const float nl2e = -1.4426950408889634f;
        c[320] = nl2e * F.ba[chh]; c[384] = nl2e * F.ba[LW + chh]; c[448] = nl2e * F.bx[chh]; c[512] = nl2e * F.bx[LW + chh]; c[576] = F.LSC[chh]; c[640] = F.LSC[LW + chh]; c[704] = 0.f; }
}

template <bool FULL>
__device__ __forceinline__ void lru_unit(Frame& F, const int ci, const int hh, const int uxoff, const int nci  , const bool first) {
    int tid = F.tid, w = F.wave; asm volatile("" : "+v"(tid)); asm volatile("" : "+s"(w));
    const int lane = tid & 63, fr = lane & 15, fq = lane >> 4, h = hh >> 1, c32 = (hh & 1) * 32;
    LAS unsigned char* lds = F.lds;
    const int row0 = ci * 256; const bool samp = ci >= NCH_P; const int q = samp ? ((ci - NCH_P) & 15) : 0;
    if (first) asm volatile("s_waitcnt vmcnt(0)" ::: "memory");
    RAW_BARRIER();
    f32x2 tq[16]; float hc0 = 0.f;
    if constexpr (FULL) { if (w == 0 && samp) { const int d = lane >> 5, cl = lane & 31, chh = h * HD + c32 + cl, b = (ci - NCH_P) >> 4;
            hc0 = F.state[(b * 2 + d) * LW + chh]; const f32x2* cg = F.CAGG + ((size_t)(b * 16) * 2 + d) * LW + chh;
#pragma unroll
            for (int qq = 0; qq < 16; ++qq) tq[qq] = cg[(size_t)qq * 2 * LW]; } }
    lru_dma(F, nci >= 0 ? nci : ci, h, c32, uxoff ^ UX_BYTES, nci >= 0, false, w, lane);
    if constexpr (FULL) lru_dma(F, ci, h, c32, 0, false, true, w, lane);
    f32x4 acc[2][8];
#ifndef LRU_DUP
#define LRU_DUP 0
#endif
#pragma unroll
    for (int rep_ = 0; rep_ <= LRU_DUP; ++rep_) { int frp_ = fr; asm volatile("" : "+v"(frp_));
    bf16x8 afr[2][2]; const int fr = frp_; (void)fr;
#pragma unroll
    for (int ks = 0; ks < 2; ++ks) { const int c = 4 * ks + fq; float cw[5][8];
#pragma unroll
        for (int p = 0; p < 5; ++p) { const f32x4 lo = *(const LAS f32x4*)(lds + CST_OFF + (p * 64 + c * 8) * 4), hi = *(const LAS f32x4*)(lds + CST_OFF + (p * 64 + c * 8 + 4) * 4);
            cw[p][0] = lo.x; cw[p][1] = lo.y; cw[p][2] = lo.z; cw[p][3] = lo.w; cw[p][4] = hi.x; cw[p][5] = hi.y; cw[p][6] = hi.z; cw[p][7] = hi.w; }
#pragma unroll
        for (int mt = 0; mt < 2; ++mt) { const int T = 32 * w + 16 * mt + fr; float xb[8];
#pragma unroll
            for (int e = 0; e < 8; ++e) xb[e] = cw[4][e];
#pragma unroll
            for (int k = 0; k < 4; ++k) { const int r = T + k; const v4u v = *(const LAS v4u*)(lds + uxoff + r * 128 + ((c ^ (r & 7)) << 4));
                xb[0] += cw[k][0] * bflo(v.x); xb[1] += cw[k][1] * bfhi(v.x); xb[2] += cw[k][2] * bflo(v.y); xb[3] += cw[k][3] * bfhi(v.y);
                xb[4] += cw[k][4] * bflo(v.z); xb[5] += cw[k][5] * bfhi(v.z); xb[6] += cw[k][6] * bflo(v.w); xb[7] += cw[k][7] * bfhi(v.w); }
            v4u o; o.x = pk2(xb[0], xb[1]); o.y = pk2(xb[2], xb[3]); o.z = pk2(xb[4], xb[5]); o.w = pk2(xb[6], xb[7]);
            afr[mt][ks] = __builtin_bit_cast(bf16x8, o); } }
#pragma unroll
    for (int mt = 0; mt < 2; ++mt)
#pragma unroll
        for (int nt = 0; nt < 8; ++nt) acc[mt][nt] = (f32x4){0.f, 0.f, 0.f, 0.f};
#pragma unroll
    for (int nt = 0; nt < 8; ++nt)
#pragma unroll
        for (int ks = 0; ks < 2; ++ks) { const bf16x8 b = *(const LAS bf16x8*)(lds + WC_OFF + (16 * nt + fr) * WSTR + (32 * ks + 8 * fq) * 2);
#pragma unroll
            for (int mt = 0; mt < 2; ++mt) acc[mt][nt] = __builtin_amdgcn_mfma_f32_16x16x32_bf16(afr[mt][ks], b, acc[mt][nt], 0, 0, 0); }
#pragma unroll
    for (int cq = 0; cq < 2; ++cq) { const int ch = c32 + 16 * cq + fr, cc = ch >> 3, ce = (ch & 7) * 2; const LAS float* c = (const LAS float*)(lds + CST_OFF) + ch;
#pragma unroll
        for (int mt = 0; mt < 2; ++mt) { float ux[7], xbf[4];
#pragma unroll
            for (int r7 = 0; r7 < 7; ++r7) { const int r = 32 * w + 16 * mt + 4 * fq + r7;
                ux[r7] = __builtin_bit_cast(float, (unsigned)(*(const LAS unsigned short*)(lds + uxoff + r * 128 + ((cc ^ (r & 7)) << 4) + ce)) << 16); }
            { const float cw0 = c[0], cw1 = c[64], cw2 = c[128], cw3 = c[192], cbv = c[256];
#pragma unroll
              for (int i = 0; i < 4; ++i) xbf[i] = cbv + cw0 * ux[i] + cw1 * ux[i + 1] + cw2 * ux[i + 2] + cw3 * ux[i + 3]; }
#pragma unroll
            for (int d = 0; d < 2; ++d) { const float bA = c[320 + 64 * d], bX = c[448 + 64 * d], c8 = c[576 + 64 * d];
#pragma unroll
                for (int i = 0; i < 4; ++i) { const float r = __builtin_amdgcn_rcpf(1.0f + __builtin_amdgcn_exp2f(acc[mt][4 * d + cq][i] + bA)), ig = __builtin_amdgcn_rcpf(1.0f + __builtin_amdgcn_exp2f(acc[mt][4 * d + 2 + cq][i] + bX));
                    const float a = __builtin_amdgcn_exp2f(r * c8), mult = __builtin_amdgcn_sqrtf(1.0f - a * a);
                    acc[mt][4 * d + cq][i] = a; acc[mt][4 * d + 2 + cq][i] = mult * (ig * xbf[i]); } } } }

    if (rep_ < LRU_DUP) {
#pragma unroll
        for (int mt = 0; mt < 2; ++mt)
#pragma unroll
            for (int nt = 0; nt < 8; ++nt) asm volatile("" :: "v"(acc[mt][nt])); } }
    float ea[2][2][2], eb[2][2][2];
    { const int ad1[2] = {((lane - 16) & 63) << 2, ((lane + 16) & 63) << 2}, ad2[2] = {((lane - 32) & 63) << 2, ((lane + 32) & 63) << 2}, adl[2] = {(fr + 48) << 2, fr << 2};
#pragma unroll
      for (int d = 0; d < 2; ++d) { const bool ok1 = d == 0 ? fq >= 1 : fq <= 2, ok2 = d == 0 ? fq >= 2 : fq <= 1;
#pragma unroll
        for (int cq = 0; cq < 2; ++cq) { float IA[2], IB[2], TA[2], TB[2], XA[2], XB[2];
#pragma unroll
            for (int mt = 0; mt < 2; ++mt) { const f32x4 a = acc[mt][4 * d + cq], b = acc[mt][4 * d + 2 + cq];
                float A = (a[0] * a[1]) * (a[2] * a[3]);
                float B = d == 0 ? ((b[0] * a[1] + b[1]) * a[2] + b[2]) * a[3] + b[3] : ((b[3] * a[2] + b[2]) * a[1] + b[1]) * a[0] + b[0];
                { const float pa = lane_from(A, ad1[d]), pb = lane_from(B, ad1[d]); if (ok1) { B = A * pb + B; A = A * pa; } }
                { const float pa = lane_from(A, ad2[d]), pb = lane_from(B, ad2[d]); if (ok2) { B = A * pb + B; A = A * pa; } }
                IA[mt] = A; IB[mt] = B;
                XA[mt] = lane_from(A, ad1[d]); XB[mt] = lane_from(B, ad1[d]); if (!ok1) { XA[mt] = 1.f; XB[mt] = 0.f; }
                TA[mt] = lane_from(A, adl[d]); TB[mt] = lane_from(B, adl[d]); }
            const int m1 = d == 0 ? 0 : 1, m2 = 1 - m1;
            ea[d][cq][m1] = XA[m1]; eb[d][cq][m1] = XB[m1];
            ea[d][cq][m2] = XA[m2] * TA[m1]; eb[d][cq][m2] = XA[m2] * TB[m1] + XB[m2];
            if (fq == 0) *(LAS f32x2*)(lds + WAGG_OFF + ((w * 2 + d) * 32 + 16 * cq + fr) * 8) = (f32x2){TA[m2] * TA[m1], TA[m2] * TB[m1] + TB[m2]}; } } }
    if (w == 0) { const int d = lane >> 5; float hc = hc0;
        if constexpr (FULL) { if (samp) {
                if (d == 0) {
#pragma unroll
                    for (int qq = 0; qq < 16; ++qq) if (qq < q) hc = tq[qq].x * hc + tq[qq].y; }
                else {
#pragma unroll
                    for (int qq = 15; qq >= 0; --qq) if (qq > q) hc = tq[qq].x * hc + tq[qq].y; } } }
        *(LAS float*)(lds + HC_OFF + lane * 4) = hc; }
    asm volatile("s_waitcnt vmcnt(0)" ::: "memory");
    RAW_BARRIER();
    if (w == 0) { const int d = lane >> 5, cl = lane & 31, chh = h * HD + c32 + cl;
        f32x2 wg[8];
#pragma unroll
        for (int ww = 0; ww < 8; ++ww) wg[ww] = *(const LAS f32x2*)(lds + WAGG_OFF + ((ww * 2 + d) * 32 + cl) * 8);
        if constexpr (FULL) { if (!samp) { float hc = 0.f;
#pragma unroll
                for (int s = 0; s < 8; ++s) { const f32x2 t = d == 0 ? wg[s] : wg[7 - s]; hc = t.x * hc + t.y; }
                F.newstate[(ci * 2 + d) * LW + chh] = hc; } }
        else { float P = 1.f, Bc = 0.f;
#pragma unroll
            for (int s = 0; s < 8; ++s) { const f32x2 t = d == 0 ? wg[s] : wg[7 - s]; Bc = t.x * Bc + t.y; P *= t.x; }
            F.CAGG[((size_t)(ci - NCH_P) * 2 + d) * LW + chh] = (f32x2){P, Bc}; } }
    if constexpr (FULL) {
#pragma unroll
        for (int cq = 0; cq < 2; ++cq) { const int cl = 16 * cq + fr;
            float hw[2];
#pragma unroll
            for (int d = 0; d < 2; ++d) { float hc = *(const LAS float*)(lds + HC_OFF + (d * 32 + cl) * 4);
#pragma unroll
                for (int s = 0; s < 7; ++s) { const int ww = d == 0 ? s : 7 - s; const f32x2 t = *(const LAS f32x2*)(lds + WAGG_OFF + ((ww * 2 + d) * 32 + cl) * 8);
                    const bool use = d == 0 ? ww < w : ww > w; if (use) hc = t.x * hc + t.y; }
                hw[d] = hc; }
#pragma unroll
            for (int mt = 0; mt < 2; ++mt) { const f32x4 a0 = acc[mt][cq], b0 = acc[mt][2 + cq], a1 = acc[mt][4 + cq], b1 = acc[mt][6 + cq];
                float hf = ea[0][cq][mt] * hw[0] + eb[0][cq][mt], hb = ea[1][cq][mt] * hw[1] + eb[1][cq][mt];
                float y[4];
#pragma unroll
                for (int i = 0; i < 4; ++i) { hf = a0[i] * hf + b0[i]; y[i] = hf; }
#pragma unroll
                for (int i = 3; i >= 0; --i) { hb = a1[i] * hb + b1[i]; y[i] += hb; }
#pragma unroll
                for (int i = 0; i < 4; ++i) { const int t = 32 * w + 16 * mt + 4 * fq + i; LAS unsigned short* p = (LAS unsigned short*)(lds + UG_OFF + t * 64 + cl * 2);
                    const float x = __builtin_bit_cast(float, (unsigned)(*p) << 16);
                    const float ge = x * fsigmoid(1.5957691216057308f * (x + 0.044715f * x * x * x));
                    *p = (unsigned short)pk2(y[i] * ge, 0.f); } } }
        RAW_BARRIER();
        const __amdgpu_buffer_rsrc_t mrs = MK_RSRC(F.MIX, (size_t)M * D * 2);
#pragma unroll
        for (int it = 0; it < 2; ++it) { const int idx = tid + it * NWAVES * 64, t = idx >> 2, c4 = idx & 3;
            ST16_WT(mrs, ((row0 + t) * D + PW + h * HD + c32 + c4 * 8) * 2, *(const LAS v4u*)(lds + UG_OFF + t * 64 + c4 * 16)); }
    }
}
template <bool FULL>
__device__ __forceinline__ void lru_units(Frame& F, const int ci_base, const int nunits) {
    if (F.vcu >= nunits) return;
    const int hh0 = F.vcu % 16;
    lru_setup(F, hh0);
    lru_dma(F, ci_base + F.vcu / 16, hh0 >> 1, (hh0 & 1) * 32, UXA_OFF, true, false, F.wave, F.lane);
    int buf = 0;
    for (int u = F.vcu; u < nunits; u += F.G, buf ^= 1) { const int un = u + F.G; const int hh = u % 16;
        if (hh != hh0) { __syncthreads(); lru_setup(F, hh); }
        lru_unit<FULL>(F, ci_base + u / 16, hh, buf ? UXB_OFF : UXA_OFF, (un < nunits && (un % 16) == hh) ? ci_base + un / 16 : -1, u == F.vcu); }
    asm volatile("s_waitcnt vmcnt(0)" ::: "memory");
    __syncthreads();
}

constexpr int UP_BYTES = 144 * 256, UP_STRIDE = 256, PM_OFF = 2 * UP_BYTES, PM_STRIDE = 272, WP_OFF = PM_OFF + 128 * PM_STRIDE;
static_assert(WP_OFF + 128 * PM_STRIDE <= MISC_OFF, "pool LDS map");
__device__ __forceinline__ void pool_setup(Frame& F, const int g) {
    const int tid = F.tid; LAS unsigned char* lds = F.lds;
#pragma unroll
    for (int it = 0; it < 4; ++it) { const int idx = tid + it * NWAVES * 64, dcol = idx >> 4, kc = idx & 15;
        *(LAS v4u*)(lds + WP_OFF + dcol * PM_STRIDE + kc * 16) = *(const GAS v4u*)(F.Wpt + ((size_t)(g * 128 + dcol) * 128 + kc * 8)); }
}
__device__ __forceinline__ void pool_dma(Frame& F, const int blk, const int g, const int upoff, const int w, const int lane) {
    LAS unsigned char* lds = F.lds; const int row0 = blk * 128; const bf16* zero = (const bf16*)((const unsigned char*)F.ctl + WS_ZERO);
#pragma unroll
    for (int j = 0; j < 5; ++j) { const int pi = w + 8 * j;
        if (pi < 36) { const int grow = row0 - 8 + 4 * pi + (lane >> 4), cg = lane & 15;
            const bf16* src = (grow >= 0 && grow < M) ? F.U + (size_t)grow * NIN + g * 128 + cg * 8 : zero + (cg & 7) * 8;
            __builtin_amdgcn_global_load_lds((const GAS unsigned*)src, (LAS unsigned*)(lds + upoff + pi * 1024), 16, 0, 0); } }
}
template <int G_>
__device__ __forceinline__ void pool_unit(Frame& F, const int blk, const int upoff, const int nblk  ) {
    constexpr int g = G_, WIN = 2 << g, LEFT = WIN / 2, RIGHT = WIN - 1 - LEFT;
    int tid = F.tid, w = F.wave; asm volatile("" : "+v"(tid)); asm volatile("" : "+s"(w));
    const int lane = tid & 63, fr = lane & 15, fq = lane >> 4;
    LAS unsigned char* lds = F.lds;
    const int row0 = blk * 128, segl = row0 < MP ? SEQ : GRIDW;
    asm volatile("s_waitcnt vmcnt(0)" ::: "memory");
    RAW_BARRIER();
    if (nblk >= 0) pool_dma(F, nblk, g, upoff ^ UP_BYTES, w, lane);
#pragma unroll
    for (int it = 0; it < 4; ++it) { const int idx = tid + it * NWAVES * 64, t = idx >> 4, cg = idx & 15, row = row0 + t;
        const int tl = row < MP ? (row & (SEQ - 1)) : ((row - MP) & (GRIDW - 1)), lo = max(tl - LEFT, 0), hi = min(tl + RIGHT + 1, segl);
        float s[8] = {0.f, 0.f, 0.f, 0.f, 0.f, 0.f, 0.f, 0.f};
#pragma unroll
        for (int p = 0; p < WIN; ++p) { const int pos = tl - LEFT + p; const bool ok = pos >= 0 && pos < segl;
            v4u v = *(const LAS v4u*)(lds + upoff + (t + 8 - LEFT + p) * UP_STRIDE + cg * 16); if (!ok) v = (v4u){0u, 0u, 0u, 0u};
            s[0] += bflo(v.x); s[1] += bfhi(v.x); s[2] += bflo(v.y); s[3] += bfhi(v.y); s[4] += bflo(v.z); s[5] += bfhi(v.z); s[6] += bflo(v.w); s[7] += bfhi(v.w); }
        const float inv = 1.0f / (float)(hi - lo);
        const v4u sv = *(const LAS v4u*)(lds + upoff + (t + 8) * UP_STRIDE + cg * 16);
        v4u o; o.x = pk2(s[0] * inv - bflo(sv.x), s[1] * inv - bfhi(sv.x)); o.y = pk2(s[2] * inv - bflo(sv.y), s[3] * inv - bfhi(sv.y));
        o.z = pk2(s[4] * inv - bflo(sv.z), s[5] * inv - bfhi(sv.z)); o.w = pk2(s[6] * inv - bflo(sv.w), s[7] * inv - bfhi(sv.w));
        *(LAS v4u*)(lds + PM_OFF + t * PM_STRIDE + cg * 16) = o; }
    RAW_BARRIER();
    f32x4 acc[8];
#pragma unroll
    for (int nt = 0; nt < 8; ++nt) acc[nt] = (f32x4){0.f, 0.f, 0.f, 0.f};
    { bf16x8 a[4];
#pragma unroll
      for (int ks = 0; ks < 4; ++ks) a[ks] = *(const LAS bf16x8*)(lds + PM_OFF + (16 * w + fr) * PM_STRIDE + (32 * ks + 8 * fq) * 2);
#pragma unroll
      for (int nt = 0; nt < 8; ++nt)
#pragma unroll
          for (int ks = 0; ks < 4; ++ks) acc[nt] = __builtin_amdgcn_mfma_f32_16x16x32_bf16(*(const LAS bf16x8*)(lds + WP_OFF + (16 * nt + fr) * PM_STRIDE + (32 * ks + 8 * fq) * 2), a[ks], acc[nt], 0, 0, 0); }
#pragma unroll
    for (int nt = 0; nt < 8; ++nt) { const int dcol = 16 * nt + 4 * fq; const f32x4 ps = *(const GAS f32x4*)(F.pscale + g * 128 + dcol);
        v2u o; o.x = pk2(acc[nt][0] * ps.x, acc[nt][1] * ps.y); o.y = pk2(acc[nt][2] * ps.z, acc[nt][3] * ps.w);
        *(LAS v2u*)(lds + upoff + (16 * w + fr) * UP_STRIDE + dcol * 2) = o; }
    RAW_BARRIER();
    const __amdgpu_buffer_rsrc_t mrs = MK_RSRC(F.MIX, (size_t)M * D * 2);
#pragma unroll
    for (int it = 0; it < 4; ++it) { const int idx = tid + it * NWAVES * 64, t = idx >> 4, cg = idx & 15;
        ST16_WT(mrs, ((row0 + t) * D + g * 128 + cg * 8) * 2, *(const LAS v4u*)(lds + upoff + t * UP_STRIDE + cg * 16)); }
}
__device__ __forceinline__ void pool_units(Frame& F, const int ubase, const int nunits) {
    int u = F.vcu; while (u < ubase) u += F.G;
    if (u >= ubase + nunits) return;
    const int g0 = (u - ubase) & 3;
    pool_setup(F, g0);
    pool_dma(F, (u - ubase) >> 2, g0, 0, F.wave, F.lane);
    int buf = 0;
    for (; u < ubase + nunits; u += F.G, buf ^= 1) { const int v = u - ubase, g = v & 3, un = u + F.G; const bool has_next = un < ubase + nunits && ((un - ubase) & 3) == g;
        if (g != g0) break;
        const int nb = has_next ? (un - ubase) >> 2 : -1, up = buf ? UP_BYTES : 0;
        switch (g) { case 0: pool_unit<0>(F, v >> 2, up, nb); break; case 1: pool_unit<1>(F, v >> 2, up, nb); break; case 2: pool_unit<2>(F, v >> 2, up, nb); break; default: pool_unit<3>(F, v >> 2, up, nb); break; } }
    asm volatile("s_waitcnt vmcnt(0)" ::: "memory");
    __syncthreads();
}

__device__ __forceinline__ void p6_rows(Frame& F) {
    const int gw = F.vcu * NWAVES + F.wave, NGW = F.G * NWAVES, lane = F.lane;
    const __amdgpu_buffer_rsrc_t ors = MK_RSRC(F.out, (size_t)M * D * 4);
    for (int row = gw; row < M; row += NGW) {
        const GAS f32x4* xr = (const GAS f32x4*)xrow(F, row) + lane; const GAS v2u* mr = (const GAS v2u*)(F.MIXO + (size_t)row * D) + lane; const float* mod = F.MOD + mod_idx(row) * NMOD;
        f32x4 v[4], x[4]; float s = 0.f;
#pragma unroll
        for (int j = 0; j < 4; ++j) { const v2u mw = mr[64 * j]; v[j] = (f32x4){bflo(mw.x), bfhi(mw.x), bflo(mw.y), bfhi(mw.y)}; x[j] = xr[64 * j]; s += (v[j].x * v[j].x + v[j].y * v[j].y) + (v[j].z * v[j].z + v[j].w * v[j].w); }
        const float r = rsqrtf(wave_sum(s) * (1.f / D) + EPS); float s2 = 0.f;
#pragma unroll
        for (int j = 0; j < 4; ++j) { const int col = 256 * j + 4 * lane;
            const f32x4 gp = *(const GAS f32x4*)(F.g_mix_post + col), g1 = *(const GAS f32x4*)(mod + 2 * D + col);
            x[j] = x[j] + g1 * (v[j] * r * gp); s2 += (x[j].x * x[j].x + x[j].y * x[j].y) + (x[j].z * x[j].z + x[j].w * x[j].w); }
        const float r2 = rsqrtf(wave_sum(s2) * (1.f / D) + EPS);
        GAS v2u* o8 = (GAS v2u*)(F.H2 + (size_t)row * D) + lane;
#pragma unroll
        for (int j = 0; j < 4; ++j) { const int col = 256 * j + 4 * lane; ST16_WT(ors, ((size_t)row * D + col) * 4, __builtin_bit_cast(v4u, x[j]));
            const f32x4 g = *(const GAS f32x4*)(F.g_ffn_pre + col), sc = *(const GAS f32x4*)(mod + 4 * D + col), sh = *(const GAS f32x4*)(mod + 3 * D + col);
            const f32x4 y = x[j] * r2 * g * (1.0f + sc) + sh; v2u wv; wv.x = pk2(y.x, y.y); wv.y = pk2(y.z, y.w); st8_wt((void*)(o8 + 64 * j), wv); }
    }
}
__device__ __forceinline__ void p9_rows(Frame& F) {
    const int gw = F.vcu * NWAVES + F.wave, NGW = F.G * NWAVES, lane = F.lane;
    for (int row = gw; row < M; row += NGW) {
        GAS f32x4* o = (GAS f32x4*)(F.out + (size_t)row * D) + lane; const GAS v2u* fr_ = (const GAS v2u*)(F.FF + (size_t)row * D) + lane; const float* mod = F.MOD + mod_idx(row) * NMOD;
        f32x4 v[4], x[4]; float s = 0.f;
#pragma unroll
        for (int j = 0; j < 4; ++j) { const v2u fw = fr_[64 * j]; v[j] = (f32x4){bflo(fw.x), bfhi(fw.x), bflo(fw.y), bfhi(fw.y)}; x[j] = o[64 * j]; s += (v[j].x * v[j].x + v[j].y * v[j].y) + (v[j].z * v[j].z + v[j].w * v[j].w); }
        const float r = rsqrtf(wave_sum(s) * (1.f / D) + EPS);
#pragma unroll
        for (int j = 0; j < 4; ++j) { const int col = 256 * j + 4 * lane;
            const f32x4 gp = *(const GAS f32x4*)(F.g_ffn_post + col), g2 = *(const GAS f32x4*)(mod + 5 * D + col);
            o[64 * j] = x[j] + g2 * (v[j] * r * gp); }
    }
}

struct Args { const float* in[24]; float* out; unsigned char* ws; int ph_lo, ph_hi; };
static_assert(sizeof(Args) == 26 * 8 + 8, "Args has no padding");
__global__ void __launch_bounds__(NWAVES * 64, 2) mega_fwd(Args args) {
    extern __shared__ __attribute__((aligned(16))) unsigned char lds[];
    Frame F;
    F.lds = (LAS unsigned char*)lds;
    F.MISC = (volatile LAS unsigned*)(F.lds + MISC_OFF);
    F.tid = threadIdx.x; F.lane = F.tid & 63; F.wave = __builtin_amdgcn_readfirstlane(F.tid >> 6);
    F.G = gridDim.x; { const int bx = blockIdx.x; F.vcu = (F.G % 8 == 0) ? (bx % 8) * (F.G / 8) + bx / 8 : bx; }
    unsigned char* ws = args.ws;
    F.ctl = (gu32*)(ws + WS_CTL);
    F.xp = args.in[0]; F.xs = args.in[1]; F.c = args.in[2]; F.state = args.in[3]; F.cctx = args.in[4]; F.wmod = args.in[5]; F.bmod = args.in[6];
    F.g_mix_pre = args.in[7]; F.g_mix_post = args.in[8]; F.g_ffn_pre = args.in[9]; F.g_ffn_post = args.in[10]; F.w_in = args.in[11]; F.w_pool = args.in[12]; F.pscale = args.in[13];
    F.convw = args.in[14]; F.convb = args.in[15]; F.wa = args.in[16]; F.ba = args.in[17]; F.wx = args.in[18]; F.bx = args.in[19]; F.lam = args.in[20];
    F.w_out = args.in[21]; F.w_fi = args.in[22]; F.w_fo = args.in[23];
    F.out = args.out; F.newstate = args.out + (size_t)M * D;
    F.MOD = (float*)(ws + WS_MOD);
    F.Win_t = (bf16*)(ws + WS_WIN); F.Wout_t = (bf16*)(ws + WS_WOUT); F.Wfi_t = (bf16*)(ws + WS_WFI); F.Wfo_t = (bf16*)(ws + WS_WFO); F.Wcat = (bf16*)(ws + WS_WCAT); F.Wpt = (bf16*)(ws + WS_WPT);
    F.LSC = (float*)(ws + WS_LSC); F.CAGG = (f32x2*)(ws + WS_CAGG);
    F.XN = (bf16*)(ws + WS_XN); F.MIX = (bf16*)(ws + WS_XN); F.H2 = (bf16*)(ws + WS_XN); F.FF = (bf16*)(ws + WS_FF);
    F.U = (bf16*)(ws + WS_U); F.MIXO = (bf16*)(ws + WS_U); F.ACT = (bf16*)(ws + WS_ACT);
    for (int u = F.tid; u < (LDS_BYTES - MISC_OFF) / 4; u += NWAVES * 64) ((LAS unsigned*)(F.lds + MISC_OFF))[u] = 0u;
    __syncthreads();
    const int lo = args.ph_lo, hi = args.ph_hi;
    XcdBarrier bar; bar.bar = (unsigned*)(F.ctl + CW_BAR); bar.x = 0; bar.st = nullptr;
    if (hi - lo > 1) bar = xcd_barrier_post((unsigned*)(F.ctl + CW_BAR), F.MISC + 8);
#ifndef PH_MASK
#define PH_MASK 0x3ff
#endif
#define IN(k) (((PH_MASK >> (k)) & 1) && lo <= (k) && (k) < hi)
#define SEAM(k) do { if (IN(k) && IN((k) + 1)) xcd_barrier(bar); } while (0)
#ifndef PROBE_REPEAT
#define PROBE_REPEAT 0
#endif
#define REPS(k) for (int rep_ = 0; rep_ <= ((PROBE_REPEAT >> (k)) & 1); ++rep_, (rep_ <= ((PROBE_REPEAT >> (k)) & 1) ? xcd_barrier(bar) : (void)0))

    if (IN(0)) REPS(0) { p0_prologue(F); } SEAM(0);
    if (IN(1)) REPS(1) { p1_xn(F); } SEAM(1);
    if (IN(2)) REPS(2) {
        pg8::Gemm g{F.XN, F.Win_t, M, NIN, D}; pg8::StaticOrder S; S.init(M, NIN, F.G, (int)blockIdx.x);
        pg8::EpiBf16<0> E{F.U, NIN, (unsigned)((size_t)M * NIN * 2)};
        pg8::gemm_phase<pg8::EpiBf16<0>, pg8::StaticOrder, true, true>(F.lds + RING_OFF, g, S, E);
    } SEAM(2);
    if (IN(3)) REPS(3) {
        lru_units<false>(F, NCH_P, NCH_S * 2 * NHEAD);
        pool_units(F, NCH_S * 2 * NHEAD, (M / 128) * 4);
    } SEAM(3);
    if (IN(4)) REPS(4) {
        lru_units<true>(F, 0, NCH * 2 * NHEAD);
    } SEAM(4);
    if (IN(5)) REPS(5) {
        pg8::Gemm g{F.MIX, F.Wout_t, M, D, D}; pg8::StaticOrder S; S.init(M, D, F.G, (int)blockIdx.x);
        pg8::EpiBf16<0> E{F.MIXO, D, (unsigned)((size_t)M * D * 2)};
        pg8::gemm_phase<pg8::EpiBf16<0>, pg8::StaticOrder, true, true>(F.lds + RING_OFF, g, S, E);
    } SEAM(5);
    if (IN(6)) REPS(6) { p6_rows(F); } SEAM(6);
    if (IN(7)) REPS(7) {
        pg8::Gemm g{F.H2, F.Wfi_t, M, 2 * DFF, D}; pg8::StaticOrder S; S.init(M, 2 * DFF, F.G, (int)blockIdx.x);
        pg8::EpiSwiglu E{F.ACT, DFF, (unsigned)((size_t)M * DFF * 2)};
        pg8::gemm_phase<pg8::EpiSwiglu, pg8::StaticOrder, true, true>(F.lds + RING_OFF, g, S, E);
    } SEAM(7);
    if (IN(8)) REPS(8) {
        pg8::Gemm g{F.ACT, F.Wfo_t, M, D, DFF}; pg8::StaticOrder S; S.init(M, D, F.G, (int)blockIdx.x);
        pg8::EpiBf16<0> E{F.FF, D, (unsigned)((size_t)M * D * 2)};
        pg8::gemm_phase<pg8::EpiBf16<0>, pg8::StaticOrder, true, true>(F.lds + RING_OFF, g, S, E);
    } SEAM(8);
    if (IN(9)) REPS(9) { p9_rows(F); }
#ifdef PROBE_TAIL
    xcd_barrier(bar);
    if (PROBE_TAIL & 1) { p0_prologue(F); xcd_barrier(bar); }
    if (PROBE_TAIL & 2) { p1_xn(F); xcd_barrier(bar); }
    if (PROBE_TAIL & 8) { lru_units<false>(F, NCH_P, NCH_S * 2 * NHEAD); pool_units(F, NCH_S * 2 * NHEAD, (M / 128) * 4); xcd_barrier(bar); }
    if (PROBE_TAIL & 0x20) { pg8::Gemm g{F.MIX, F.Wout_t, M, D, D}; pg8::StaticOrder S; S.init(M, D, F.G, (int)blockIdx.x); pg8::EpiBf16<0> E{F.MIXO, D, (unsigned)((size_t)M * D * 2)};
        pg8::gemm_phase<pg8::EpiBf16<0>, pg8::StaticOrder, true, true>(F.lds + RING_OFF, g, S, E); xcd_barrier(bar); }
    if (PROBE_TAIL & 4) { pg8::Gemm g{F.XN, F.Win_t, M, NIN, D}; pg8::StaticOrder S; S.init(M, NIN, F.G, (int)blockIdx.x); pg8::EpiBf16<0> E{F.U, NIN, (unsigned)((size_t)M * NIN * 2)};
        pg8::gemm_phase<pg8::EpiBf16<0>, pg8::StaticOrder, true, true>(F.lds + RING_OFF, g, S, E); xcd_barrier(bar); }
    if (PROBE_TAIL & 0x80) { pg8::Gemm g{F.H2, F.Wfi_t, M, 2 * DFF, D}; pg8::StaticOrder S; S.init(M, 2 * DFF, F.G, (int)blockIdx.x); pg8::EpiSwiglu E{F.ACT, DFF, (unsigned)((size_t)M * DFF * 2)};
        pg8::gemm_phase<pg8::EpiSwiglu, pg8::StaticOrder, true, true>(F.lds + RING_OFF, g, S, E); xcd_barrier(bar); }
    if (PROBE_TAIL & 0x100) { pg8::Gemm g{F.ACT, F.Wfo_t, M, D, DFF}; pg8::StaticOrder S; S.init(M, D, F.G, (int)blockIdx.x); pg8::EpiBf16<0> E{F.FF, D, (unsigned)((size_t)M * D * 2)};
        pg8::gemm_phase<pg8::EpiBf16<0>, pg8::StaticOrder, true, true>(F.lds + RING_OFF, g, S, E); xcd_barrier(bar); }
#endif
#undef IN
#undef SEAM
}

extern "C" void kernel_launch(void* const* d_in, const int* in_sizes, int n_in, void* d_out, int out_size, void* d_ws, size_t ws_size, hipStream_t stream) {
    static int grid = 0;
    if (grid == 0) {
        if (n_in != 24 || in_sizes[0] != MP * D || in_sizes[1] != MS * D || out_size != M * D + NB * 2 * LW || ws_size < WS_END) {
            fprintf(stderr, "kernel_launch: unexpected shapes: n_in %d, in0 %d, in1 %d, out %d, ws %zu; nothing launched\n", n_in, n_in > 0 ? in_sizes[0] : -1, n_in > 1 ? in_sizes[1] : -1, out_size, ws_size); grid = -1; return; }
        int dev = 0, cus = 0, per_cu = 0;
        if (hipGetDevice(&dev) != hipSuccess || hipDeviceGetAttribute(&cus, hipDeviceAttributeMultiprocessorCount, dev) != hipSuccess) { fprintf(stderr, "kernel_launch: device query failed\n"); grid = -1; return; }
        if (hipFuncSetAttribute((const void*)mega_fwd, hipFuncAttributeMaxDynamicSharedMemorySize, LDS_BYTES) != hipSuccess) { fprintf(stderr, "kernel_launch: hipFuncSetAttribute failed\n"); grid = -1; return; }
        if (hipOccupancyMaxActiveBlocksPerMultiprocessor(&per_cu, (const void*)mega_fwd, NWAVES * 64, LDS_BYTES) != hipSuccess || per_cu < 1) {
            fprintf(stderr, "kernel_launch: occupancy query reports %d workgroups per CU: the grid cannot be resident; nothing launched\n", per_cu); (void)hipGetLastError(); grid = -1; return; }
        grid = cus;
    }
    if (grid < 0) return;
    if (hipMemsetAsync((char*)d_ws + WS_CTL, 0, CTL_ZERO_BYTES, stream) != hipSuccess) { fprintf(stderr, "kernel_launch: hipMemsetAsync failed\n"); return; }
    Args a{};
    for (int i = 0; i < 24; ++i) a.in[i] = (const float*)d_in[i];
    a.out = (float*)d_out; a.ws = (unsigned char*)d_ws;
#if MK_ONE_LAUNCH
    a.ph_lo = 0; a.ph_hi = N_PHASES;
    hipLaunchKernelGGL(mega_fwd, dim3(grid), dim3(NWAVES * 64), LDS_BYTES, stream, a);
#else
    for (int p = 0; p < N_PHASES; ++p) { a.ph_lo = p; a.ph_hi = p + 1; hipLaunchKernelGGL(mega_fwd, dim3(grid), dim3(NWAVES * 64), LDS_BYTES, stream, a); }
#endif
    const hipError_t le = hipPeekAtLastError();
    if (le != hipSuccess) fprintf(stderr, "kernel_launch: launch failed: %s (grid %d x %d threads, %d B LDS)\n", hipGetErrorName(le), grid, NWAVES * 64, LDS_BYTES);
}
```
